# Optimizing an MI355X kernel written in HIP

```python
import jax, jax.numpy as jnp
from jax import lax
import numpy as np

D_MODEL = 1024
BATCH = 8
SEQ = 4096
DEPTH = 1

CHUNK = 64
Q_BLOCK = 128
SB_HEADS = 8
SB_HEAD_DIM = 64
SB_WIDTH = SB_HEADS * SB_HEAD_DIM
GLA_HEADS = 4
GLA_KEY_WIDTH = D_MODEL // 2
GLA_VALUE_WIDTH = D_MODEL
GLA_DK = GLA_KEY_WIDTH // GLA_HEADS
GLA_DV = GLA_VALUE_WIDTH // GLA_HEADS
GLA_GATE_RANK = 16
GLA_GATE_TAU = 16.0
D_FF = 4 * D_MODEL
EPS = 1e-6

SPLIT_SIZES = (SB_WIDTH, SB_WIDTH, SB_WIDTH,
               GLA_KEY_WIDTH, GLA_KEY_WIDTH, GLA_VALUE_WIDTH, GLA_VALUE_WIDTH, GLA_GATE_RANK,
               D_MODEL, D_MODEL)
D_IN = 3 * SB_WIDTH + 2 * GLA_KEY_WIDTH + 2 * GLA_VALUE_WIDTH + GLA_GATE_RANK + 2 * D_MODEL

kernel_name = 'hybrid_stickbreak_gla_sqrelu_block'


def rms_norm(x, g):
    xf = x.astype(jnp.float32)
    y = xf * lax.rsqrt(jnp.mean(xf * xf, axis=-1, keepdims=True) + EPS)
    return (y * g.astype(jnp.float32)).astype(x.dtype)


def split_heads(t, n_heads):
    b, s, _ = t.shape
    return t.reshape(b, s, n_heads, -1).transpose(0, 2, 1, 3)


def merge_heads(t):
    b, h, s, d = t.shape
    return t.transpose(0, 2, 1, 3).reshape(b, s, h * d)


def stick_breaking_attention(q, k, v):
    _, _, s_len, d = q.shape
    scale = d ** -0.5
    outs = []
    for start in range(0, s_len, Q_BLOCK):
        end = start + Q_BLOCK
        kb = k[:, :, :end]
        vb = v[:, :, :end]
        z = jnp.einsum('bhtd,bhsd->bhts', q[:, :, start:end], kb) * scale
        t_idx = start + jnp.arange(Q_BLOCK)[:, None]
        s_idx = jnp.arange(end)[None, :]
        past = s_idx < t_idx
        log_beta = jax.nn.log_sigmoid(z)
        log_fail = jnp.where(past, log_beta - z, 0.0)
        later = lax.cumsum(log_fail, axis=3, reverse=True) - log_fail
        w = jnp.where(past, jnp.exp(log_beta + later), 0.0)
        outs.append(jnp.einsum('bhts,bhsd->bhtd', w, vb))
    return jnp.concatenate(outs, axis=2)


def gla_chunked(q, k, v, log_a):
    b, h, s_len, dk = q.shape
    dv = v.shape[-1]
    nc = s_len // CHUNK

    def to_chunks(t):
        return t.reshape(b, h, nc, CHUNK, t.shape[-1]).transpose(2, 0, 1, 3, 4)

    qc, kc, vc, ac = (to_chunks(t) for t in (q * dk ** -0.5, k, v, log_a))
    bc = jnp.cumsum(ac, axis=3)
    causal = jnp.tril(jnp.ones((CHUNK, CHUNK), dtype=bool))

    def step(state, inp):
        qi, ki, vi, bi = inp
        b_last = bi[:, :, -1:, :]
        o_inter = jnp.einsum('bhtk,bhkv->bhtv', qi * jnp.exp(bi), state)
        diff = bi[:, :, :, None, :] - bi[:, :, None, :, :]
        decay = jnp.exp(jnp.where(causal[:, :, None], diff, -jnp.inf))
        scores = jnp.einsum('bhtk,bhsk,bhtsk->bhts', qi, ki, decay)
        o_intra = jnp.einsum('bhts,bhsv->bhtv', scores, vi)
        new_state = (jnp.exp(b_last[:, :, 0, :, None]) * state
                     + jnp.einsum('bhsk,bhsv->bhkv', ki * jnp.exp(b_last - bi), vi))
        return new_state, o_inter + o_intra

    state0 = jnp.zeros((b, h, dk, dv), jnp.float32)
    _, o = lax.scan(step, state0, (qc, kc, vc, bc))
    return o.transpose(1, 2, 0, 3, 4).reshape(b, h, s_len, dv)


def setup_inputs(seed: int = 0) -> dict:
    key = jax.random.key(seed)
    ks = jax.random.split(key, 16)
    f32 = jnp.float32

    def w(k, shape, fan_in):
        return jax.random.normal(k, shape, f32) * (fan_in ** -0.5)

    def gain(k, shape):
        return 1.0 + 0.02 * jax.random.normal(k, shape, f32)

    return {
        'x': jax.random.normal(ks[0], (BATCH, SEQ, D_MODEL), f32),
        'norm_mix': gain(ks[1], (DEPTH, D_MODEL)),
        'w_in': w(ks[2], (DEPTH, D_MODEL, D_IN), D_MODEL),
        'w_gate_up': w(ks[3], (DEPTH, GLA_GATE_RANK, GLA_KEY_WIDTH), GLA_GATE_RANK),
        'b_gate_up': 0.1 * jax.random.normal(ks[4], (DEPTH, GLA_KEY_WIDTH), f32),
        'gla_norm': gain(ks[5], (DEPTH, GLA_DV)),
        'w_proj_sb': w(ks[6], (DEPTH, SB_WIDTH, D_MODEL), SB_WIDTH),
        'w_proj_gla': w(ks[7], (DEPTH, GLA_VALUE_WIDTH, D_MODEL), GLA_VALUE_WIDTH),
        'w_out': w(ks[8], (DEPTH, D_MODEL, D_MODEL), D_MODEL),
        'norm_mlp': gain(ks[9], (DEPTH, D_MODEL)),
        'w_ff1': w(ks[10], (DEPTH, D_MODEL, D_FF), D_MODEL),
        'w_ff2': w(ks[11], (DEPTH, D_FF, D_MODEL), D_FF),
        'norm_final': gain(ks[12], (D_MODEL,)),
    }


def reference(x, norm_mix, w_in, w_gate_up, b_gate_up, gla_norm, w_proj_sb, w_proj_gla,
              w_out, norm_mlp, w_ff1, w_ff2, norm_final):
    f32 = jnp.float32
    bsz, s_len, _ = x.shape
    split_points = np.cumsum(SPLIT_SIZES)[:-1].tolist()
    for layer in range(DEPTH):
        h = rms_norm(x, norm_mix[layer])
        proj = h @ w_in[layer]
        (sb_q, sb_k, sb_v, g_q, g_k, g_v, g_out, g_low, gate_sb, gate_gla) = jnp.split(
            proj, split_points, axis=-1)

        o_sb = stick_breaking_attention(split_heads(sb_q, SB_HEADS).astype(f32),
                                        split_heads(sb_k, SB_HEADS).astype(f32),
                                        split_heads(sb_v, SB_HEADS).astype(f32))
        o_sb = merge_heads(o_sb).astype(x.dtype)

        log_a = jax.nn.log_sigmoid((g_low @ w_gate_up[layer] + b_gate_up[layer]).astype(f32)) / GLA_GATE_TAU
        o_gla = gla_chunked(split_heads(g_q, GLA_HEADS).astype(f32),
                            split_heads(g_k, GLA_HEADS).astype(f32),
                            split_heads(g_v, GLA_HEADS).astype(f32),
                            split_heads(log_a, GLA_HEADS))
        o_gla = o_gla.transpose(0, 2, 1, 3)
        o_gla = rms_norm(o_gla, gla_norm[layer])
        o_gla = o_gla * jax.nn.silu(g_out.astype(f32).reshape(bsz, s_len, GLA_HEADS, GLA_DV))
        o_gla = o_gla.reshape(bsz, s_len, GLA_VALUE_WIDTH).astype(x.dtype)

        mix = (jax.nn.sigmoid(gate_sb) * (o_sb @ w_proj_sb[layer])
               + jax.nn.sigmoid(gate_gla) * (o_gla @ w_proj_gla[layer]))
        x = x + mix @ w_out[layer]

        h2 = rms_norm(x, norm_mlp[layer])
        x = x + jnp.square(jax.nn.relu(h2 @ w_ff1[layer])) @ w_ff2[layer]
    return rms_norm(x, norm_final)
```

```cpp
#include <hip/hip_runtime.h>
#include <hip/hip_cooperative_groups.h>
#include <cstdio>
#include <cstdint>
namespace cg = cooperative_groups;
namespace pg8 {
#define PG8_LAS __attribute__((address_space(3)))
typedef unsigned short bf16_t;
typedef short bf16x8 __attribute__((ext_vector_type(8)));
typedef float f32x4 __attribute__((ext_vector_type(4)));
typedef unsigned u32x4 __attribute__((ext_vector_type(4)));
constexpr int BM = 256, BK = 64, HALF = 128, HTB = HALF * BK * 2  , STAGE_BYTES = 8 * HTB, NXCD = 8, WGM = 8;

__host__ __device__ __forceinline__ int lds_byte(int r, int c) { const int st = (r >> 4) * 2 + (c >> 5), rr = r & 15, cc = c & 31, ob = rr * 64 + cc * 2; return st * 1024 + (ob ^ (((ob >> 9) & 1) << 5)); }
__host__ __device__ __forceinline__ void stage_rc(int b, int& R, int& C) { const int st = b / 1024, sb = b % 1024, swz = sb ^ (((sb >> 9) & 1) << 5); R = (st >> 1) * 16 + swz / 64; C = (st & 1) * 32 + (swz % 64) / 2; }
__host__ __device__ __forceinline__ int perm32(int rho) { const int n = rho >> 4, i = rho & 15; return 8 * (i >> 2) + 4 * n + (i & 3); }

struct Unit { int pm, pn; };
struct Gemm { const bf16_t* A; const bf16_t* Bt; int M, N, K; };

struct StaticOrder {
    int nM, nN, nwg, G, c;
    __host__ __device__ void init(int M, int N, int G_, int c_) { nM = M / BM; nN = N / BM; nwg = nM * nN; G = G_; c = c_; }
    __host__ __device__ bool next(int i, Unit& u) const {
        const long L = (long)i * G + c; if (L >= nwg) return false;
        int wgid = (int)L; { const int q = nwg / NXCD, r = nwg % NXCD, xcd = wgid % NXCD, off = wgid / NXCD; wgid = (xcd < r ? xcd * (q + 1) : r * (q + 1) + (xcd - r) * q) + off; }
        const int nig = WGM * nN, gid = wgid / nig, fm = gid * WGM, gsz = (nM - fm) < WGM ? (nM - fm) : WGM;
        u.pm = fm + ((wgid % nig) % gsz); u.pn = (wgid % nig) / gsz; return true;
    }
    __device__ __forceinline__ void a_ready(const Unit&) const {}
    __device__ __forceinline__ void done(const Unit&) const {}
};

__device__ __forceinline__ unsigned cvt_pk_bf16(float lo, float hi) { unsigned r; asm volatile("v_cvt_pk_bf16_f32 %0, %1, %2" : "=v"(r) : "v"(lo), "v"(hi)); return r; }
template <class Epi, class Sched, bool ALIGN_EPI = false, bool SP2 = false>
__device__ __forceinline__ void gemm_phase(PG8_LAS unsigned char* lds, const Gemm g, const Sched& S, const Epi& E) {
    int tid_ = threadIdx.x; asm volatile("" : "+v"(tid_));
    const int tid = tid_, wid = __builtin_amdgcn_readfirstlane(tid >> 6), lane = tid & 63, wr = wid >> 2, wc = wid & 3, fr = lane & 15, fq = lane >> 4;
    const int K = g.K, nt = K / BK;
    unsigned voffA[2], voffB[2];
#pragma unroll
    for (int i = 0; i < 2; ++i) { int R, C; stage_rc(tid * 16 + i * 8192, R, C); const int Rb = Epi::PERM ? ((R & ~31) + perm32(R & 31)) : R;
        voffA[i] = (unsigned)(R * K + C) * 2u; voffB[i] = (unsigned)(Rb * K + C) * 2u; }
    const size_t kstep = (size_t)(BK * 2);
    const size_t hstep = (size_t)HALF * K * 2;
    const size_t tstep = 2 * hstep;
    const unsigned ldsw = (unsigned)wid * 1024u;
    const int aoff = lds_byte(wr * 64 + fr, fq * 8), boff = lds_byte(wc * 32 + fr, fq * 8);
#define PG8_SA(b, h) (((b) * 2 + (h)) * HTB)
#define PG8_SB(b, h) ((4 + (b) * 2 + (h)) * HTB)
#define PG8_STAGE(bufoff, gbase, voff) do { _Pragma("unroll") for (int _i = 0; _i < 2; ++_i) \
        __builtin_amdgcn_global_load_lds((const unsigned*)((const char*)(gbase) + (voff)[_i]), (PG8_LAS unsigned*)(lds + (bufoff) + ldsw + _i * 8192), 16, 0, 0); } while (0)
#define PG8_LDA(dst, b, h) do { _Pragma("unroll") for (int m = 0; m < 4; ++m) _Pragma("unroll") for (int k = 0; k < 2; ++k) dst[m][k] = *(const PG8_LAS bf16x8*)(lds + PG8_SA(b, h) + aoff + m * 2048 + k * 1024); } while (0)
#define PG8_LDB(dst, b, h) do { _Pragma("unroll") for (int n = 0; n < 2; ++n) _Pragma("unroll") for (int k = 0; k < 2; ++k) dst[n][k] = *(const PG8_LAS bf16x8*)(lds + PG8_SB(b, h) + boff + n * 2048 + k * 1024); } while (0)
#define PG8_MMA(ai, bj, At, Bt) do { __builtin_amdgcn_s_setprio(1); _Pragma("unroll") for (int m = 0; m < 4; ++m) _Pragma("unroll") for (int n = 0; n < 2; ++n) _Pragma("unroll") for (int k = 0; k < 2; ++k) \
        acc[ai][bj][m][n] = __builtin_amdgcn_mfma_f32_16x16x32_bf16(Bt[n][k], At[m][k], acc[ai][bj][m][n], 0, 0, 0); __builtin_amdgcn_s_setprio(0); } while (0)
#define PG8_WAIT_V(n) asm volatile("s_waitcnt vmcnt(" #n ")" ::: "memory")
#define PG8_WAIT_L(n) asm volatile("s_waitcnt lgkmcnt(" #n ")" ::: "memory")
#define PG8_BAR __builtin_amdgcn_s_barrier()
#define PG8_SCHED __builtin_amdgcn_sched_barrier(0)
    Unit cur, nxt; int ui = 0;
    if (!S.next(0, cur)) return;
    f32x4 acc[2][2][4][2];
#pragma unroll
    for (int a = 0; a < 2; ++a)
#pragma unroll
        for (int b = 0; b < 2; ++b)
#pragma unroll
            for (int m = 0; m < 4; ++m)
#pragma unroll
                for (int n = 0; n < 2; ++n) acc[a][b][m][n] = (f32x4){0.f, 0.f, 0.f, 0.f};
    bf16x8 At[4][2], B0[2][2], B1[2][2];
    const char* cA = (const char*)g.A + (size_t)cur.pm * tstep; const char* cB = (const char*)g.Bt + (size_t)cur.pn * tstep;
    S.a_ready(cur);
    if constexpr (SP2) {
        PG8_STAGE(PG8_SB(0, 0), cB, voffB); PG8_STAGE(PG8_SB(0, 1), cB + hstep, voffB); PG8_STAGE(PG8_SA(0, 0), cA, voffA); PG8_STAGE(PG8_SA(0, 1), cA + hstep, voffA);
        if (wr == 1) PG8_BAR;
        PG8_WAIT_V(2); PG8_BAR;
        PG8_STAGE(PG8_SB(1, 0), cB + kstep, voffB); PG8_STAGE(PG8_SA(1, 0), cA + kstep, voffA); PG8_STAGE(PG8_SB(1, 1), cB + hstep + kstep, voffB);
        PG8_WAIT_V(6); PG8_BAR;
    } else {
        PG8_STAGE(PG8_SB(0, 0), cB, voffB); PG8_STAGE(PG8_SA(0, 0), cA, voffA); PG8_STAGE(PG8_SB(0, 1), cB + hstep, voffB); PG8_STAGE(PG8_SA(0, 1), cA + hstep, voffA);
        if (wr == 1) PG8_BAR;
        PG8_WAIT_V(4); PG8_BAR;
        PG8_STAGE(PG8_SB(1, 0), cB + kstep, voffB); PG8_STAGE(PG8_SA(1, 0), cA + kstep, voffA); PG8_STAGE(PG8_SB(1, 1), cB + hstep + kstep, voffB);
        PG8_WAIT_V(6); PG8_BAR;
    }
    for (;;) {
        const bool has_next = S.next(ui + 1, nxt);
        const char* nA = has_next ? (const char*)g.A + (size_t)nxt.pm * tstep : cA; const char* nB = has_next ? (const char*)g.Bt + (size_t)nxt.pn * tstep : cB;
        for (int t = 0; t < nt; t += 2) {
            if constexpr (Epi::MIDK > 0) { if (t == Epi::MIDK) E.mid(acc, cur, wr, wc, fr, fq); }
            const bool last = (t == nt - 2);
            const char* a1 = cA + (size_t)(t + 1) * kstep;
            const char* a2 = last ? nA : cA + (size_t)(t + 2) * kstep; const char* b2 = last ? nB : cB + (size_t)(t + 2) * kstep;
            const char* a3 = a2 + kstep; const char* b3 = b2 + kstep;
            if (last && has_next) S.a_ready(nxt);
            if constexpr (SP2) {
            PG8_LDB(B0, 0, 0); PG8_LDB(B1, 0, 1); PG8_SCHED; PG8_LDA(At, 0, 0); PG8_STAGE(PG8_SA(1, 1), a1 + hstep, voffA);
            PG8_WAIT_V(8); PG8_WAIT_L(0); PG8_BAR; PG8_MMA(0, 0, At, B0); PG8_MMA(0, 1, At, B1); PG8_BAR; PG8_SCHED;
            PG8_LDA(At, 0, 1); PG8_STAGE(PG8_SB(0, 0), b2, voffB); PG8_STAGE(PG8_SB(0, 1), b2 + hstep, voffB); PG8_STAGE(PG8_SA(0, 0), a2, voffA);
            PG8_WAIT_V(8); PG8_WAIT_L(0); PG8_BAR; PG8_MMA(1, 0, At, B0); PG8_MMA(1, 1, At, B1); PG8_BAR; PG8_SCHED;
            PG8_LDB(B0, 1, 0); PG8_LDB(B1, 1, 1); PG8_SCHED; PG8_LDA(At, 1, 0); PG8_STAGE(PG8_SA(0, 1), a2 + hstep, voffA);
            PG8_WAIT_V(8); PG8_WAIT_L(0); PG8_BAR; PG8_MMA(0, 0, At, B0); PG8_MMA(0, 1, At, B1); PG8_BAR; PG8_SCHED;
            PG8_LDA(At, 1, 1); PG8_STAGE(PG8_SB(1, 0), b3, voffB); PG8_STAGE(PG8_SB(1, 1), b3 + hstep, voffB); PG8_STAGE(PG8_SA(1, 0), a3, voffA);
            PG8_WAIT_V(8); PG8_WAIT_L(0); PG8_BAR; PG8_MMA(1, 0, At, B0); PG8_MMA(1, 1, At, B1); PG8_BAR; PG8_SCHED;
            } else {
            PG8_LDB(B0, 0, 0); PG8_SCHED; PG8_LDA(At, 0, 0); PG8_STAGE(PG8_SA(1, 1), a1 + hstep, voffA);
            PG8_WAIT_L(8); PG8_BAR; PG8_WAIT_L(0); PG8_MMA(0, 0, At, B0); PG8_BAR; PG8_SCHED;
            PG8_LDB(B1, 0, 1); PG8_STAGE(PG8_SB(0, 0), b2, voffB);
            PG8_BAR; PG8_WAIT_L(0); PG8_MMA(0, 1, At, B1); PG8_BAR;
            PG8_LDA(At, 0, 1); PG8_STAGE(PG8_SA(0, 0), a2, voffA);
            PG8_BAR; PG8_WAIT_L(0); PG8_MMA(1, 0, At, B0); PG8_BAR; PG8_SCHED;
            PG8_STAGE(PG8_SB(0, 1), b2 + hstep, voffB);
            PG8_WAIT_V(6); PG8_BAR; PG8_MMA(1, 1, At, B1); PG8_BAR;
            PG8_LDB(B0, 1, 0); PG8_SCHED; PG8_LDA(At, 1, 0); PG8_STAGE(PG8_SA(0, 1), a2 + hstep, voffA);
            PG8_WAIT_L(8); PG8_BAR; PG8_WAIT_L(0); PG8_MMA(0, 0, At, B0); PG8_BAR; PG8_SCHED;
            PG8_LDB(B1, 1, 1); PG8_STAGE(PG8_SB(1, 0), b3, voffB);
            PG8_BAR; PG8_WAIT_L(0); PG8_MMA(0, 1, At, B1); PG8_BAR;
            PG8_LDA(At, 1, 1); PG8_STAGE(PG8_SA(1, 0), a3, voffA);
            PG8_BAR; PG8_WAIT_L(0); PG8_MMA(1, 0, At, B0); PG8_BAR; PG8_SCHED;
            PG8_STAGE(PG8_SB(1, 1), b3 + hstep, voffB);
            PG8_WAIT_V(6); PG8_BAR; PG8_MMA(1, 1, At, B1); PG8_BAR;
            }
        }
        if constexpr (ALIGN_EPI) { if (wr == 0) PG8_BAR; }
        if constexpr (!Epi::AFTER_DRAIN) { E(acc, cur, wr, wc, fr, fq); S.done(cur); }
        if (!has_next) break;
#pragma unroll
        for (int a = 0; a < 2; ++a)
#pragma unroll
            for (int b = 0; b < 2; ++b)
#pragma unroll
                for (int m = 0; m < 4; ++m)
#pragma unroll
                    for (int n = 0; n < 2; ++n) acc[a][b][m][n] = (f32x4){0.f, 0.f, 0.f, 0.f};
        cur = nxt; cA = nA; cB = nB; ++ui;
        if constexpr (ALIGN_EPI) { if (wr == 1) PG8_BAR; }
    }
    PG8_WAIT_V(0);
    if constexpr (!ALIGN_EPI) { if (wr == 0) PG8_BAR; }
    PG8_BAR;
    if constexpr (Epi::AFTER_DRAIN) { E.fused(acc, cur, wr, wc, fr, fq, lds, wid, lane); S.done(cur); }
#undef PG8_SA
#undef PG8_SB
#undef PG8_STAGE
#undef PG8_LDA
#undef PG8_LDB
#undef PG8_MMA
#undef PG8_WAIT_V
#undef PG8_WAIT_L
#undef PG8_BAR
#undef PG8_SCHED
}
}

#define LAS __attribute__((address_space(3)))
typedef unsigned short bf16_t;
typedef short bf16x8 __attribute__((ext_vector_type(8)));
typedef float f32x4 __attribute__((ext_vector_type(4)));
typedef float f32x16 __attribute__((ext_vector_type(16)));
typedef unsigned u32x4 __attribute__((ext_vector_type(4)));
typedef unsigned u32x2 __attribute__((ext_vector_type(2)));

constexpr int NB = 8, SEQ = 4096, T = NB * SEQ, D = 1024, FF = 4096, DIN = 6672;
constexpr int NWIN = 6912;
constexpr float EPS = 1e-6f;
constexpr size_t MiB = 1u << 20;
constexpr size_t WS_SS1 = 0, WS_SS2 = 128 * 1024, WS_DSEG = 256 * 1024, WS_ED = 3 * MiB, WS_KT = 420 * MiB;
constexpr size_t WS_GLOW = 1 * MiB, WS_WIN = 4 * MiB, WS_WPA = 18 * MiB, WS_WPB = 19 * MiB, WS_WOUT = 21 * MiB, WS_W1 = 23 * MiB, WS_W2 = 31 * MiB;
constexpr size_t WS_X2B = 104 * MiB;
constexpr size_t WS_HB = 40 * MiB, WS_OC = 40 * MiB, WS_GATES = 136 * MiB, WS_GQ = 264 * MiB, WS_GK = 296 * MiB, WS_QH = 328 * MiB, WS_KH = 360 * MiB, WS_SLOC = 392 * MiB, WS_VT = 452 * MiB, WS_HID = 232 * MiB, WS_END = 488 * MiB;
constexpr size_t DO_GVT = 0, DO_GO = 64 * MiB;
constexpr int LDS_BYTES = 147456, MISC_OFF = LDS_BYTES - 64;
constexpr size_t WS_BAR = 512 * 1024;

__device__ __forceinline__ float bf2f(unsigned short v) { return __uint_as_float((unsigned)v << 16); }
__device__ __forceinline__ float bflo(unsigned v) { return __uint_as_float(v << 16); }
__device__ __forceinline__ float bfhi(unsigned v) { return __uint_as_float(v & 0xffff0000u); }
__device__ __forceinline__ unsigned pk2(float lo, float hi) { return pg8::cvt_pk_bf16(lo, hi); }
__device__ __forceinline__ unsigned short f2bf(float f) { return (unsigned short)(pg8::cvt_pk_bf16(f, 0.f) & 0xffffu); }
typedef float f32x2_t __attribute__((ext_vector_type(2))); typedef __bf16 bf16x2_t __attribute__((ext_vector_type(2)));
__device__ __forceinline__ unsigned pk2_v(float lo, float hi) { f32x2_t v = {lo, hi}; bf16x2_t b = __builtin_convertvector(v, bf16x2_t); return __builtin_bit_cast(unsigned, b); }
__device__ __forceinline__ unsigned short f2bf_v(float f) { f32x2_t v = {f, 0.f}; bf16x2_t b = __builtin_convertvector(v, bf16x2_t); return (unsigned short)(__builtin_bit_cast(unsigned, b) & 0xffffu); }
__device__ __forceinline__ float fexp(float x) { return __expf(x); }
__device__ __forceinline__ float softplus(float z) { return fmaxf(z, 0.f) + __logf(1.f + __expf(-fabsf(z))); }
__device__ __forceinline__ float sigmoidf(float x) { return __builtin_amdgcn_rcpf(1.f + __expf(-x)); }
__device__ __forceinline__ float wave_sum(float v) {
#pragma unroll
    for (int o = 1; o < 64; o <<= 1) v += __shfl_xor(v, o);
    return v;
}
__device__ __forceinline__ bf16x8 pack8(float a0, float a1, float a2, float a3, float a4, float a5, float a6, float a7) {
    u32x4 w; w.x = pk2(a0, a1); w.y = pk2(a2, a3); w.z = pk2(a4, a5); w.w = pk2(a6, a7); return __builtin_bit_cast(bf16x8, w);
}
#define LDS_WAIT() asm volatile("s_waitcnt lgkmcnt(0)" ::: "memory")
#define LDS_BARRIER() do { asm volatile("s_waitcnt lgkmcnt(0)" ::: "memory"); __builtin_amdgcn_s_barrier(); asm volatile("" ::: "memory"); } while (0)

enum { E_INPROJ = 0, E_PMIX = 1, E_WOUT = 3, E_FF1 = 4, E_FF2 = 5 };
template <int MODE> struct Epi {
    static constexpr bool PERM = (MODE == E_INPROJ || MODE == E_PMIX || MODE == E_FF1), AFTER_DRAIN = false;
    static constexpr int MIDK = (MODE == E_PMIX) ? 8 : 0;
    bf16_t* QH; bf16_t* KH; bf16_t* GQ; bf16_t* GK; bf16_t* GO; bf16_t* GATES; bf16_t* VT; bf16_t* GVT; float* GLOW;
    bf16_t* MIX;
    const float* XIN; const bf16_t* XBIN; bf16_t* XB; float* SS;
    bf16_t* HID;
    static __device__ __forceinline__ float sigB(float g) { return __builtin_amdgcn_rcpf(1.f + fminf(__expf(-g), 1e20f)); }
    static __device__ __forceinline__ float ratioAB(float ga, float gb) { return (1.f + fminf(__expf(-gb), 1e20f)) * __builtin_amdgcn_rcpf(1.f + __expf(-ga)); }
    __device__ __forceinline__ void mid(f32x4 (&acc)[2][2][4][2], const pg8::Unit& u, int wr, int wc, int fr, int fq) const {
        if constexpr (MODE == E_PMIX) {
            int fr_ = fr, fq_ = fq; asm volatile("" : "+v"(fr_), "+v"(fq_));
            const int row0 = u.pm * 256 + wr * 64 + fr_, col0 = u.pn * 256 + wc * 32 + 8 * fq_;
#pragma unroll
            for (int ai = 0; ai < 2; ++ai)
#pragma unroll
                for (int m = 0; m < 4; ++m) { const size_t r = (size_t)(row0 + ai * 128 + m * 16);
#pragma unroll
                    for (int bj = 0; bj < 2; ++bj) {
                        const u32x4 ga = *(const u32x4*)(GATES + r * 2048 + col0 + bj * 128), gb = *(const u32x4*)(GATES + r * 2048 + 1024 + col0 + bj * 128);
                        f32x4 r0, r1;
                        r0[0] = ratioAB(bflo(ga.x), bflo(gb.x)); r0[1] = ratioAB(bfhi(ga.x), bfhi(gb.x)); r0[2] = ratioAB(bflo(ga.y), bflo(gb.y)); r0[3] = ratioAB(bfhi(ga.y), bfhi(gb.y));
                        r1[0] = ratioAB(bflo(ga.z), bflo(gb.z)); r1[1] = ratioAB(bfhi(ga.z), bfhi(gb.z)); r1[2] = ratioAB(bflo(ga.w), bflo(gb.w)); r1[3] = ratioAB(bfhi(ga.w), bfhi(gb.w));
                        acc[ai][bj][m][0] *= r0; acc[ai][bj][m][1] *= r1; }
                    if (m & 1) asm volatile("" ::: "memory"); }
        }
    }
    __device__ __forceinline__ void operator()(const f32x4 (&acc)[2][2][4][2], const pg8::Unit& u, int wr, int wc, int fr, int fq) const {
        const int row0 = u.pm * 256 + wr * 64 + fr;
        if constexpr (MODE == E_INPROJ) {
            if (u.pn < 20) {
                const int b = u.pm >> 4, s0 = (u.pm & 15) * 256 + wr * 64 + fr;
                bf16_t* base; size_t off0, rstride, bjstride;
                if (u.pn < 4) { base = (u.pn < 2) ? QH : KH;
                    off0 = ((size_t)(b * 8 + (u.pn & 1) * 4 + (wc >> 1)) * SEQ + s0) * 64 + (wc & 1) * 32 + 8 * fq; rstride = 64; bjstride = (size_t)2 * SEQ * 64; }
                else if (u.pn < 8) { base = (u.pn < 6) ? GQ : GK;
                    off0 = ((size_t)(b * 4 + (u.pn & 1) * 2) * SEQ + s0) * 128 + wc * 32 + 8 * fq; rstride = 128; bjstride = (size_t)SEQ * 128; }
                else if (u.pn < 12) { base = GO; off0 = (size_t)row0 * 1024 + (u.pn - 8) * 256 + wc * 32 + 8 * fq; rstride = 1024; bjstride = 128; }
                else { base = GATES; off0 = (size_t)row0 * 2048 + (u.pn - 12) * 256 + wc * 32 + 8 * fq; rstride = 2048; bjstride = 128; }
#pragma unroll
                for (int ai = 0; ai < 2; ++ai)
#pragma unroll
                    for (int m = 0; m < 4; ++m) { bf16_t* rowp = base + off0 + (size_t)(ai * 128 + m * 16) * rstride;
#pragma unroll
                        for (int bj = 0; bj < 2; ++bj) { const f32x4 v0 = acc[ai][bj][m][0], v1 = acc[ai][bj][m][1];
                            u32x4 w; w.x = pk2(v0[0], v0[1]); w.y = pk2(v0[2], v0[3]); w.z = pk2(v1[0], v1[1]); w.w = pk2(v1[2], v1[3]);
                            *(u32x4*)(rowp + bj * bjstride) = w; } }
            } else if (u.pn < 26) {
                const int b = u.pm >> 4, ck0 = (u.pm & 15) * 4 + wr;
                const int ncol = (u.pn < 22) ? 512 : 1024;
                bf16_t* dst = (u.pn < 22) ? VT : GVT;
                dst += (((size_t)(b * 64 + ck0) * ncol) + ((u.pn < 22) ? (u.pn - 20) : (u.pn - 22)) * 256 + wc * 32 + 8 * fq) * 64 + fr;
#pragma unroll
                for (int ai = 0; ai < 2; ++ai)
#pragma unroll
                    for (int m = 0; m < 4; ++m)
#pragma unroll
                        for (int bj = 0; bj < 2; ++bj)
#pragma unroll
                            for (int n = 0; n < 2; ++n) { const f32x4 v = acc[ai][bj][m][n];
#pragma unroll
                                for (int e = 0; e < 4; ++e) dst[((size_t)(2 * ai) * ncol + bj * 128 + 4 * n + e) * 64 + m * 16] = f2bf(v[e]); }
            } else {
                if (wc == 0 && fq < 2) {
#pragma unroll
                    for (int ai = 0; ai < 2; ++ai)
#pragma unroll
                        for (int m = 0; m < 4; ++m)
#pragma unroll
                            for (int n = 0; n < 2; ++n) *(f32x4*)(GLOW + (size_t)(row0 + ai * 128 + m * 16) * 16 + 8 * fq + 4 * n) = acc[ai][0][m][n];
                }
            }
        } else if constexpr (MODE == E_PMIX) {
            const int col0 = u.pn * 256 + wc * 32 + 8 * fq;
#pragma unroll
            for (int ai = 0; ai < 2; ++ai)
#pragma unroll
                for (int m = 0; m < 4; ++m) { const size_t r = (size_t)(row0 + ai * 128 + m * 16);
#pragma unroll
                    for (int bj = 0; bj < 2; ++bj) {
                        const u32x4 g = *(const u32x4*)(GATES + r * 2048 + 1024 + col0 + bj * 128);
                        const f32x4 v0 = acc[ai][bj][m][0], v1 = acc[ai][bj][m][1];
                        float o[8];
                        o[0] = v0[0] * sigB(bflo(g.x)); o[1] = v0[1] * sigB(bfhi(g.x)); o[2] = v0[2] * sigB(bflo(g.y)); o[3] = v0[3] * sigB(bfhi(g.y));
                        o[4] = v1[0] * sigB(bflo(g.z)); o[5] = v1[1] * sigB(bfhi(g.z)); o[6] = v1[2] * sigB(bflo(g.w)); o[7] = v1[3] * sigB(bfhi(g.w));
                        u32x4 w; w.x = pk2(o[0], o[1]); w.y = pk2(o[2], o[3]); w.z = pk2(o[4], o[5]); w.w = pk2(o[6], o[7]);
                        *(u32x4*)(MIX + r * D + col0 + bj * 128) = w; } }
        } else if constexpr (MODE == E_WOUT || MODE == E_FF2) {
            const int col0 = u.pn * 256 + wc * 32 + 4 * fq;
#pragma unroll
            for (int ai = 0; ai < 2; ++ai)
#pragma unroll
                for (int m = 0; m < 4; ++m) { const size_t r = (size_t)(row0 + ai * 128 + m * 16); float ss = 0.f;
#pragma unroll
                    for (int bj = 0; bj < 2; ++bj)
#pragma unroll
                        for (int n = 0; n < 2; ++n) { const size_t off = r * D + col0 + bj * 128 + n * 16;
                            f32x4 xv;
                            if constexpr (MODE == E_WOUT) xv = *(const f32x4*)(XIN + off);
                            else { const u32x2 xb = *(const u32x2*)(XBIN + off); xv = (f32x4){bflo(xb.x), bfhi(xb.x), bflo(xb.y), bfhi(xb.y)}; }
                            const f32x4 o = xv + acc[ai][bj][m][n];
                            ss += (o[0] * o[0] + o[1] * o[1]) + (o[2] * o[2] + o[3] * o[3]);
                            u32x2 w; w.x = pk2(o[0], o[1]); w.y = pk2(o[2], o[3]); *(u32x2*)(XB + off) = w; }
                    ss += __shfl_xor(ss, 16); ss += __shfl_xor(ss, 32);
                    if (fq == 0) unsafeAtomicAdd(SS + r, ss); }
        } else {
            const int col0 = u.pn * 256 + wc * 32 + 8 * fq;
#pragma unroll
            for (int ai = 0; ai < 2; ++ai)
#pragma unroll
                for (int m = 0; m < 4; ++m) { const size_t r = (size_t)(row0 + ai * 128 + m * 16);
                    const float rs = rsqrtf(SS[r] * (1.f / D) + EPS);
#pragma unroll
                    for (int bj = 0; bj < 2; ++bj) { f32x4 v0 = acc[ai][bj][m][0] * rs, v1 = acc[ai][bj][m][1] * rs;
#pragma unroll
                        for (int e = 0; e < 4; ++e) { const float a = fmaxf(v0[e], 0.f), c = fmaxf(v1[e], 0.f); v0[e] = a * a; v1[e] = c * c; }
                        u32x4 w; w.x = pk2(v0[0], v0[1]); w.y = pk2(v0[2], v0[3]); w.z = pk2(v1[0], v1[1]); w.w = pk2(v1[2], v1[3]);
                        *(u32x4*)(HID + r * FF + col0 + bj * 128) = w; } }
        }
    }
};

__device__ __forceinline__ int win_src(int n) {
    if (n < 1024) return n;
    if (n < 2048) return n + 512;
    if (n < 3072) return n + 1536;
    if (n < 5120) return n + 1552;
    if (n < 5632) return n - 4096;
    if (n < 6656) return n - 3072;
    if (n < 6672) return n - 2048;
    return -1;
}
__device__ __forceinline__ void transpose_item(const float* W, int K, int Nsrc, bf16_t* WT, int n0, int k0, int kdst, int srccol, const float* kscale, LAS float* scr, int lane) {
#pragma unroll 8
    for (int i = 0; i < 32; ++i) { const int kk = 2 * i + (lane >> 5); float v = 0.f;
        if (srccol >= 0) v = W[(size_t)(k0 + kk) * Nsrc + srccol];
        if (kscale) v *= kscale[k0 + kk];
        scr[kk * 33 + (lane & 31)] = v; }
    LDS_WAIT();
    const int c = lane & 7;
#pragma unroll
    for (int j = 0; j < 4; ++j) { const int n = (lane >> 3) + 8 * j; const LAS float* s = scr + (8 * c) * 33 + n;
        u32x4 o; o.x = pk2(s[0 * 33], s[1 * 33]); o.y = pk2(s[2 * 33], s[3 * 33]); o.z = pk2(s[4 * 33], s[5 * 33]); o.w = pk2(s[6 * 33], s[7 * 33]);
        *(u32x4*)(WT + (size_t)(n0 + n) * K + kdst + 8 * c) = o; }
    LDS_WAIT();
}

__device__ __forceinline__ void sb_tile(const bf16x8 (&kf)[4], const bf16x8 (&va)[4], const bf16x8 (&qf)[4], f32x16& o0, f32x16& o1, float& carry, bool diag, int l32, int hi) {
    f32x16 z;
#pragma unroll
    for (int r = 0; r < 16; ++r) z[r] = 0.f;
#pragma unroll
    for (int st = 0; st < 4; ++st) z = __builtin_amdgcn_mfma_f32_32x32x16_bf16(kf[st], qf[st], z, 0, 0, 0);
    float wv[16]; float run = 1.f;
#pragma unroll
    for (int r = 15; r >= 0; --r) {
        const float zz = z[r] * 0.125f, tt = __expf(-fabsf(zz)), rr = __builtin_amdgcn_rcpf(1.f + tt), b2 = tt * rr;
        float beta = zz >= 0.f ? rr : b2, fail = zz >= 0.f ? b2 : rr;
        if (diag) { const bool valid = (16 * hi + r < l32); beta = valid ? beta : 0.f; fail = valid ? fail : 1.f; }
        wv[r] = beta * run; run *= fail;
    }
    const float other = __shfl_xor(run, 32);
    const float add = carry * (hi == 0 ? other : 1.f);
#pragma unroll
    for (int r = 0; r < 16; ++r) wv[r] *= add;
    carry *= run * other;
    const bf16x8 pb0 = pack8(wv[0], wv[1], wv[2], wv[3], wv[4], wv[5], wv[6], wv[7]);
    const bf16x8 pb1 = pack8(wv[8], wv[9], wv[10], wv[11], wv[12], wv[13], wv[14], wv[15]);
    o0 = __builtin_amdgcn_mfma_f32_32x32x16_bf16(va[0], pb0, o0, 0, 0, 0);
    o0 = __builtin_amdgcn_mfma_f32_32x32x16_bf16(va[1], pb1, o0, 0, 0, 0);
    o1 = __builtin_amdgcn_mfma_f32_32x32x16_bf16(va[2], pb0, o1, 0, 0, 0);
    o1 = __builtin_amdgcn_mfma_f32_32x32x16_bf16(va[3], pb1, o1, 0, 0, 0);
}
__device__ __forceinline__ void sb_attn_unit(const bf16_t* __restrict__ QH, const bf16_t* __restrict__ KH, const bf16_t* __restrict__ VT, bf16_t* __restrict__ OSB, int b, int h, int qt, int lane_) {
    int lane = lane_; asm volatile("" : "+v"(lane));
    const int l32 = lane & 31, hi = lane >> 5, t0 = qt * 32;
    const size_t rowb = (size_t)b * SEQ;
    const size_t hb = (size_t)(b * 8 + h) * SEQ;
    const bf16_t* qrow = QH + (hb + t0 + l32) * 64 + 8 * hi;
    bf16x8 qf[4];
#pragma unroll
    for (int st = 0; st < 4; ++st) qf[st] = *(const bf16x8*)(qrow + 16 * st);
    f32x16 o0, o1;
#pragma unroll
    for (int r = 0; r < 16; ++r) { o0[r] = 0.f; o1[r] = 0.f; }
    float carry = 1.f;
    const int kperm = 16 * ((l32 >> 2) & 1) + (l32 & 3) + 4 * (l32 >> 3);
    bf16x8 k0[4], v0[4], k1[4], v1[4], k2[4], v2[4];
#define SB_LOAD(KF, VA, s0_) do { const bf16_t* krow_ = KH + (hb + (s0_) + kperm) * 64 + 8 * hi; \
        const bf16_t* vb_ = VT + (((size_t)(b * 64 + ((s0_) >> 6)) * 512 + h * 64 + l32) * 64 + ((s0_) & 63) + 16 * hi); \
        _Pragma("unroll") for (int st = 0; st < 4; ++st) KF[st] = *(const bf16x8*)(krow_ + 16 * st); \
        VA[0] = *(const bf16x8*)(vb_); VA[1] = *(const bf16x8*)(vb_ + 8); VA[2] = *(const bf16x8*)(vb_ + 32 * 64); VA[3] = *(const bf16x8*)(vb_ + 32 * 64 + 8); } while (0)
#define SB_STEP(KC, VC, KP, VP, DIAG) { { const int sp_ = s0 >= 64 ? s0 - 64 : 0; SB_LOAD(KP, VP, sp_); }     \
        sb_tile(KC, VC, qf, o0, o1, carry, DIAG, l32, hi); if (s0 < 32 || __all(carry == 0.f)) break; s0 -= 32; }
    SB_LOAD(k0, v0, t0);
    { const int sp_ = t0 >= 32 ? t0 - 32 : 0; SB_LOAD(k1, v1, sp_); }
    for (int s0 = t0; ; ) {
        SB_STEP(k0, v0, k2, v2, s0 == t0)
        SB_STEP(k1, v1, k0, v0, false)
        SB_STEP(k2, v2, k1, v1, false)
    }
#undef SB_STEP
#undef SB_LOAD
    bf16_t* orow = OSB + (rowb + t0 + l32) * 1536 + h * 64 + 4 * hi;
#pragma unroll
    for (int g = 0; g < 4; ++g) {
        u32x2 w0, w1; w0.x = pk2_v(o0[4 * g], o0[4 * g + 1]); w0.y = pk2_v(o0[4 * g + 2], o0[4 * g + 3]); w1.x = pk2_v(o1[4 * g], o1[4 * g + 1]); w1.y = pk2_v(o1[4 * g + 2], o1[4 * g + 3]);
        *(u32x2*)(orow + 8 * g) = w0; *(u32x2*)(orow + 32 + 8 * g) = w1;
    }
}

__device__ __forceinline__ void split_hl(float a, float b, unsigned& h, unsigned& l) { h = pk2(a, b); l = pk2(a - bflo(h), b - bfhi(h)); }
__device__ __forceinline__ void split8(float v0, float v1, float v2, float v3, float v4, float v5, float v6, float v7, bf16x8& hv, bf16x8& lv) {
    unsigned h0, h1, h2, h3, l0, l1, l2, l3; split_hl(v0, v1, h0, l0); split_hl(v2, v3, h1, l1); split_hl(v4, v5, h2, l2); split_hl(v6, v7, h3, l3);
    u32x4 ph, pl; ph.x = h0; ph.y = h1; ph.z = h2; ph.w = h3; pl.x = l0; pl.y = l1; pl.z = l2; pl.w = l3; hv = __builtin_bit_cast(bf16x8, ph); lv = __builtin_bit_cast(bf16x8, pl); }
__device__ __forceinline__ void gla_prep_unit(LAS bf16_t* lq, bf16_t* GQ, bf16_t* GK, const float* __restrict__ GLOW, const float* __restrict__ Wgu, const float* __restrict__ bgu, bf16_t* __restrict__ KT, float* __restrict__ ED, int bh, int chunk, int cb, int lane_) {
    int lane = lane_; asm volatile("" : "+v"(lane));
    const int b = bh >> 2, h = bh & 3, l32 = lane & 31, hi = lane >> 5, c = 32 * cb + l32;
    const size_t tok0 = (size_t)b * SEQ + chunk * 64;
    bf16x8 wh, wl;
    { float wv[8];
#pragma unroll
      for (int j = 0; j < 8; ++j) wv[j] = Wgu[(8 * hi + j) * 512 + h * 128 + c];
      split8(wv[0], wv[1], wv[2], wv[3], wv[4], wv[5], wv[6], wv[7], wh, wl); }
    const float bg = bgu[h * 128 + c];
    const size_t tile = ((size_t)bh * 64 + chunk) * 8192;
    bf16_t* pt = KT + tile + c * 64 + 4 * hi;
    LAS bf16_t* lk = lq + 64 * 40;
    u32x4 gq4[4], gk4[4];
#pragma unroll
    for (int j = 0; j < 4; ++j) { const int idx = lane + 64 * j, row = idx >> 2, part = idx & 3; const size_t o_ = tile + (size_t)row * 128 + cb * 32 + part * 8;
        gq4[j] = *(const u32x4*)(GQ + o_); gk4[j] = *(const u32x4*)(GK + o_); }
    bf16x8 ltri[2], lone;
#pragma unroll
    for (int op = 0; op < 2; ++op)
#pragma unroll
        for (int j = 0; j < 8; ++j) { const int r = 8 * op + j, tp = (r & 3) + 8 * (r >> 2) + 4 * hi; ltri[op][j] = (tp <= l32) ? (short)0x3F80 : (short)0; }
#pragma unroll
    for (int j = 0; j < 8; ++j) lone[j] = (short)0x3F80;
    f32x16 la[2];
#pragma unroll
    for (int tb = 0; tb < 2; ++tb) {
        const float* gp = GLOW + (tok0 + 32 * tb + l32) * 16 + 8 * hi;
        const f32x4 g0 = *(const f32x4*)gp, g1 = *(const f32x4*)(gp + 4);
        bf16x8 ahv, alv; split8(g0[0], g0[1], g0[2], g0[3], g1[0], g1[1], g1[2], g1[3], ahv, alv);
        f32x16 x;
#pragma unroll
        for (int r = 0; r < 16; ++r) x[r] = bg;
        x = __builtin_amdgcn_mfma_f32_32x32x16_bf16(alv, wh, x, 0, 0, 0);
        x = __builtin_amdgcn_mfma_f32_32x32x16_bf16(ahv, wl, x, 0, 0, 0);
        x = __builtin_amdgcn_mfma_f32_32x32x16_bf16(ahv, wh, x, 0, 0, 0);
#pragma unroll
        for (int r = 0; r < 16; ++r) la[tb][r] = -softplus(-x[r]) * (1.f / 16.f);
    }
    bf16x8 bhv[2][2], blv[2][2];
#pragma unroll
    for (int tb = 0; tb < 2; ++tb)
#pragma unroll
        for (int op = 0; op < 2; ++op) split8(la[tb][8 * op], la[tb][8 * op + 1], la[tb][8 * op + 2], la[tb][8 * op + 3], la[tb][8 * op + 4], la[tb][8 * op + 5], la[tb][8 * op + 6], la[tb][8 * op + 7], bhv[tb][op], blv[tb][op]);
    f32x16 bc[2];
#pragma unroll
    for (int tb = 0; tb < 2; ++tb) {
#pragma unroll
        for (int r = 0; r < 16; ++r) bc[tb][r] = 0.f;
#pragma unroll
        for (int op = 0; op < 2; ++op) {
            bc[tb] = __builtin_amdgcn_mfma_f32_32x32x16_bf16(ltri[op], blv[tb][op], bc[tb], 0, 0, 0);
            bc[tb] = __builtin_amdgcn_mfma_f32_32x32x16_bf16(ltri[op], bhv[tb][op], bc[tb], 0, 0, 0);
        }
    }
#pragma unroll
    for (int op = 0; op < 2; ++op) {
        bc[1] = __builtin_amdgcn_mfma_f32_32x32x16_bf16(lone, blv[0][op], bc[1], 0, 0, 0);
        bc[1] = __builtin_amdgcn_mfma_f32_32x32x16_bf16(lone, bhv[0][op], bc[1], 0, 0, 0);
    }
#pragma unroll
    for (int j = 0; j < 4; ++j) { const int idx = lane + 64 * j, row = idx >> 2, part = idx & 3; *(LAS u32x4*)(lq + row * 40 + part * 8) = gq4[j]; *(LAS u32x4*)(lk + row * 40 + part * 8) = gk4[j]; }
    LDS_WAIT();
    const float t63 = __shfl(bc[1][15], 32 + l32);
#pragma unroll
    for (int tb = 0; tb < 2; ++tb)
#pragma unroll
        for (int g4 = 0; g4 < 4; ++g4) {
            float kh[4];
#pragma unroll
            for (int e = 0; e < 4; ++e) { const int r = 4 * g4 + e, t = 32 * tb + 8 * g4 + 4 * hi + e;
                const float bcv = bc[tb][r], ee = fexp(bcv), ei = fexp(-bcv);
                const float qv = bf2f(lq[t * 40 + l32]), kv = bf2f(lk[t * 40 + l32]);
                kh[e] = kv * ei;
                lq[t * 40 + l32] = f2bf(qv * 0.08838834764831845f * ee); lk[t * 40 + l32] = f2bf(kh[e]); }
            u32x2 w; w.x = pk2(kh[0], kh[1]); w.y = pk2(kh[2], kh[3]);
            *(u32x2*)(pt + 32 * tb + 8 * g4) = w;
        }
    if (hi == 0) ED[((size_t)bh * 64 + chunk) * 128 + c] = fexp(t63);
    LDS_WAIT();
#pragma unroll
    for (int j = 0; j < 4; ++j) { const int idx = lane + 64 * j, row = idx >> 2, part = idx & 3; const size_t o_ = tile + (size_t)row * 128 + cb * 32 + part * 8;
        *(u32x4*)(GQ + o_) = *(const LAS u32x4*)(lq + row * 40 + part * 8); *(u32x4*)(GK + o_) = *(const LAS u32x4*)(lk + row * 40 + part * 8); }
    LDS_WAIT();
}

__device__ __forceinline__ void gla_state_block(LAS unsigned char* lds, const bf16_t* __restrict__ KT, const bf16_t* __restrict__ GVT, const float* __restrict__ ED, float* __restrict__ SLOC, float* __restrict__ DSEG, int bh, int seg) {
    int tid_ = threadIdx.x; asm volatile("" : "+v"(tid_));
    const int tid = tid_, lane = tid & 63, w = __builtin_amdgcn_readfirstlane(tid >> 6), l32 = lane & 31, hi = lane >> 5, b = bh >> 2, h = bh & 3;
    f32x16 S[4];
#pragma unroll
    for (int kt = 0; kt < 4; ++kt)
#pragma unroll
        for (int r = 0; r < 16; ++r) S[kt][r] = 0.f;
    bf16x8 vnx[4]; u32x4 ktn[2]; float edn = 0.f, dprod = 1.f;
#define GLA_ALOADS(chx) do { const size_t ck_ = (size_t)bh * 64 + seg * 8 + (chx); \
        { const bf16_t* vp_ = GVT + (((size_t)b * 64 + seg * 8 + (chx)) * 1024 + h * 256 + 32 * w + l32) * 64 + 8 * hi; _Pragma("unroll") for (int st = 0; st < 4; ++st) vnx[st] = *(const bf16x8*)(vp_ + 16 * st); } \
        _Pragma("unroll") for (int i = 0; i < 2; ++i) ktn[i] = *(const u32x4*)(KT + ck_ * 8192 + (size_t)(tid + 512 * i) * 8); \
        if (tid < 128) edn = ED[ck_ * 128 + tid]; } while (0)
    GLA_ALOADS(0);
    for (int ch = 0; ch < 8; ++ch) {
        LAS bf16_t* KTT = (LAS bf16_t*)(lds + (ch & 1) * 18432); LAS float* EDEC = (LAS float*)(lds + 36864 + (ch & 1) * 512);
#pragma unroll
        for (int i = 0; i < 2; ++i) { const int id = tid + 512 * i; *(LAS u32x4*)(KTT + (id >> 3) * 72 + (id & 7) * 8) = ktn[i]; }
        if (tid < 128) { EDEC[tid] = edn; dprod *= edn; }
        bf16x8 vreg[4];
#pragma unroll
        for (int st = 0; st < 4; ++st) vreg[st] = vnx[st];
        if (ch < 7) GLA_ALOADS(ch + 1);
        __builtin_amdgcn_sched_barrier(0);
        LDS_BARRIER();
#pragma unroll
        for (int kt = 0; kt < 4; ++kt) {
#pragma unroll
            for (int st = 0; st < 4; ++st) { const bf16x8 av = *(const LAS bf16x8*)(KTT + (32 * kt + l32) * 72 + 16 * st + 8 * hi);
                S[kt] = __builtin_amdgcn_mfma_f32_32x32x16_bf16(av, vreg[st], S[kt], 0, 0, 0); }
#pragma unroll
            for (int gq = 0; gq < 4; ++gq) { const f32x4 d4 = *(const LAS f32x4*)(EDEC + 32 * kt + 8 * gq + 4 * hi);
#pragma unroll
                for (int e = 0; e < 4; ++e) S[kt][4 * gq + e] *= d4[e]; }
        }
    }
#undef GLA_ALOADS
    float* sl = SLOC + (((size_t)(bh * 7 + seg) * 8 + w) * 64) * 64 + lane;
#pragma unroll
    for (int kt = 0; kt < 4; ++kt)
#pragma unroll
        for (int r = 0; r < 16; ++r) sl[(size_t)(kt * 16 + r) * 64] = S[kt][r];
    if (tid < 128) DSEG[(bh * 8 + seg) * 128 + tid] = dprod;
    LDS_BARRIER();
}

constexpr int G_QT = 0, G_KH = 17408, G_KTT = 34816, G_SC = 53248, G_EDEC = 62464, G_OS = 62976, G_GN = 130560;
struct GlaPtrs { const bf16_t* GQ; const bf16_t* GK; const bf16_t* GO; const bf16_t* GVT; const bf16_t* KT; const float* ED; const float* gn; bf16_t* OGLA; const float* SLOC; const float* DSEG; };

__device__ __forceinline__ void gla_out_unit(LAS unsigned char* lds, const GlaPtrs& g, int bh, int seg) {
    int tid_ = threadIdx.x; asm volatile("" : "+v"(tid_));
    const int tid = tid_, lane = tid & 63, w = __builtin_amdgcn_readfirstlane(tid >> 6), l32 = lane & 31, hi = lane >> 5;
    const int b = bh >> 2, h = bh & 3;
    LAS bf16_t* QT = (LAS bf16_t*)(lds + G_QT); LAS bf16_t* KH = (LAS bf16_t*)(lds + G_KH); LAS bf16_t* KTT = (LAS bf16_t*)(lds + G_KTT); LAS bf16_t* SC = (LAS bf16_t*)(lds + G_SC);
    LAS float* EDEC = (LAS float*)(lds + G_EDEC); LAS float* OS = (LAS float*)(lds + G_OS);
    f32x16 S[4];
#pragma unroll
    for (int kt = 0; kt < 4; ++kt)
#pragma unroll
        for (int r = 0; r < 16; ++r) S[kt][r] = 0.f;
    if (seg > 0) {
        LAS float* DST = OS;
        for (int i = tid; i < seg * 128; i += 512) DST[i] = g.DSEG[(bh * 8) * 128 + i];
        LDS_BARRIER();
        for (int j = 0; j < seg; ++j) {
            const float* sl = g.SLOC + (((size_t)(bh * 7 + j) * 8 + w) * 64) * 64 + lane;
#pragma unroll
            for (int kt = 0; kt < 4; ++kt)
#pragma unroll
                for (int gq = 0; gq < 4; ++gq) { const f32x4 d4 = *(const LAS f32x4*)(DST + j * 128 + 32 * kt + 8 * gq + 4 * hi);
#pragma unroll
                    for (int e = 0; e < 4; ++e) S[kt][4 * gq + e] = S[kt][4 * gq + e] * d4[e] + sl[(size_t)(kt * 16 + 4 * gq + e) * 64]; }
        }
        LDS_BARRIER();
    }
    bf16x8 vreg[4]; u32x4 qn[2], kn[2], ktn[2]; float edn = 0.f;
    LAS float* GN = (LAS float*)(lds + G_GN);
    LAS bf16_t* OSB2 = (LAS bf16_t*)(lds + G_OS);
    if (tid < 256) GN[tid] = g.gn[tid];
    const bool j1first = ((w & 1) == 0);
#define GLA_LOADS(chx) do { const size_t ck_ = (size_t)bh * 64 + seg * 8 + (chx); \
        _Pragma("unroll") for (int i = 0; i < 2; ++i) { const size_t o_ = ck_ * 8192 + (size_t)(tid + 512 * i) * 8; \
            qn[i] = *(const u32x4*)(g.GQ + o_); kn[i] = *(const u32x4*)(g.GK + o_); ktn[i] = *(const u32x4*)(g.KT + o_); } \
        edn = g.ED[ck_ * 128 + (tid & 127)]; } while (0)
#define GLA_VLOAD(chx) do { const bf16_t* vp_ = g.GVT + (((size_t)b * 64 + seg * 8 + (chx)) * 1024 + h * 256 + 32 * w + l32) * 64 + 8 * hi; _Pragma("unroll") for (int st = 0; st < 4; ++st) vreg[st] = *(const bf16x8*)(vp_ + 16 * st); } while (0)
    GLA_LOADS(0); GLA_VLOAD(0);
    for (int ch = 0; ch <= 8; ++ch) {
        const bool has = ch < 8;
        const int cp = ch > 0 ? ch - 1 : 0;
        const size_t tokp = (size_t)b * SEQ + seg * 512 + cp * 64;
        if (has) {
#pragma unroll
            for (int i = 0; i < 2; ++i) { const int id = tid + 512 * i;
                *(LAS u32x4*)(QT + (id >> 4) * 136 + (id & 15) * 8) = qn[i]; *(LAS u32x4*)(KH + (id >> 4) * 136 + (id & 15) * 8) = kn[i]; *(LAS u32x4*)(KTT + (id >> 3) * 72 + (id & 7) * 8) = ktn[i]; }
            if (tid < 128) EDEC[tid] = edn;
            GLA_LOADS(ch < 7 ? ch + 1 : 7);
        }
        __builtin_amdgcn_sched_barrier(0);
        LDS_BARRIER();
        if (has) {
            const int l16 = lane & 15, q4 = lane >> 4, ti = w >> 1;
#pragma unroll
            for (int sjj = 0; sjj < 2; ++sjj) { const int sj = 2 * (w & 1) + sjj; f32x4 a4 = (f32x4){0.f, 0.f, 0.f, 0.f};
#pragma unroll
                for (int kk = 0; kk < 4; ++kk) { const bf16x8 av = *(const LAS bf16x8*)(KH + (16 * sj + l16) * 136 + 32 * kk + 8 * q4); const bf16x8 bv = *(const LAS bf16x8*)(QT + (16 * ti + l16) * 136 + 32 * kk + 8 * q4);
                    a4 = __builtin_amdgcn_mfma_f32_16x16x32_bf16(av, bv, a4, 0, 0, 0); }
                const int tt_ = 16 * ti + l16, ss_ = 16 * sj + 4 * q4;
                u32x2 wv; wv.x = pk2(ss_ <= tt_ ? a4[0] : 0.f, ss_ + 1 <= tt_ ? a4[1] : 0.f); wv.y = pk2(ss_ + 2 <= tt_ ? a4[2] : 0.f, ss_ + 3 <= tt_ ? a4[3] : 0.f);
                *(LAS u32x2*)(SC + tt_ * 72 + ss_) = wv; }
        }
        LDS_BARRIER();
        auto J1 = [&]() __attribute__((always_inline)) {
            {
                if (has) {
                    LAS bf16_t* ob = OSB2 + (ch & 1) * (64 * 264) + 32 * w + l32;
#pragma unroll 1
                    for (int tt = 0; tt < 2; ++tt) {
                        f32x16 o;
#pragma unroll
                        for (int r = 0; r < 16; ++r) o[r] = 0.f;
#pragma unroll
                        for (int kt = 0; kt < 4; ++kt)
#pragma unroll
                            for (int op = 0; op < 2; ++op) {
                                const bf16x8 bs = pack8(S[kt][8 * op], S[kt][8 * op + 1], S[kt][8 * op + 2], S[kt][8 * op + 3], S[kt][8 * op + 4], S[kt][8 * op + 5], S[kt][8 * op + 6], S[kt][8 * op + 7]);
                                const LAS bf16_t* ap = QT + (32 * tt + l32) * 136 + 32 * kt + 16 * op + 4 * hi;
                                const u32x2 a0 = *(const LAS u32x2*)ap, a1 = *(const LAS u32x2*)(ap + 8);
                                u32x4 aw; aw.x = a0.x; aw.y = a0.y; aw.z = a1.x; aw.w = a1.y;
                                o = __builtin_amdgcn_mfma_f32_32x32x16_bf16(__builtin_bit_cast(bf16x8, aw), bs, o, 0, 0, 0); }
#pragma unroll
                        for (int st = 0; st < 4; ++st) { const bf16x8 av = *(const LAS bf16x8*)(SC + (32 * tt + l32) * 72 + 16 * st + 8 * hi);
                            o = __builtin_amdgcn_mfma_f32_32x32x16_bf16(av, vreg[st], o, 0, 0, 0); }
#pragma unroll
                        for (int r = 0; r < 16; ++r) ob[(32 * tt + (r & 3) + 8 * (r >> 2) + 4 * hi) * 264] = f2bf_v(o[r]);
                    }
#pragma unroll
                    for (int kt = 0; kt < 4; ++kt) {
#pragma unroll
                        for (int st = 0; st < 4; ++st) { const bf16x8 av = *(const LAS bf16x8*)(KTT + (32 * kt + l32) * 72 + 16 * st + 8 * hi);
                            S[kt] = __builtin_amdgcn_mfma_f32_32x32x16_bf16(av, vreg[st], S[kt], 0, 0, 0); }
#pragma unroll
                        for (int gq = 0; gq < 4; ++gq) { const f32x4 d4 = *(const LAS f32x4*)(EDEC + 32 * kt + 8 * gq + 4 * hi);
#pragma unroll
                            for (int e = 0; e < 4; ++e) S[kt][4 * gq + e] *= d4[e]; }
                    }
                    GLA_VLOAD(ch < 7 ? ch + 1 : 7);
                }
            }
        };
        auto J2 = [&]() __attribute__((always_inline)) {
            {
                if (ch > 0) {
                    const int t = tid >> 3, part = tid & 7;
                    u32x4 gocur[4];
                    { const bf16_t* gop_ = g.GO + (tokp + t) * 1024 + h * 256 + 32 * part;
#pragma unroll
                      for (int i = 0; i < 4; ++i) gocur[i] = *(const u32x4*)(gop_ + 8 * i); }
                    const LAS u32x4* op4 = (const LAS u32x4*)(OSB2 + (cp & 1) * (64 * 264) + t * 264 + 32 * part);
                    float ss = 0.f;
#pragma unroll
                    for (int i = 0; i < 4; ++i) { const u32x4 x = op4[i];
                        ss += (bflo(x.x) * bflo(x.x) + bfhi(x.x) * bfhi(x.x)) + (bflo(x.y) * bflo(x.y) + bfhi(x.y) * bfhi(x.y)) + (bflo(x.z) * bflo(x.z) + bfhi(x.z) * bfhi(x.z)) + (bflo(x.w) * bflo(x.w) + bfhi(x.w) * bfhi(x.w)); }
                    ss += __shfl_xor(ss, 1); ss += __shfl_xor(ss, 2); ss += __shfl_xor(ss, 4);
                    const float rs = rsqrtf(ss * (1.f / 256.f) + EPS);
                    bf16_t* dst = g.OGLA + (tokp + t) * 1536 + 512 + h * 256 + 32 * part; const LAS float* gnp = GN + 32 * part;
#pragma unroll
                    for (int i = 0; i < 4; ++i) { const u32x4 gw = gocur[i]; const u32x4 x = op4[i];
                        const float v[8] = {bflo(x.x), bfhi(x.x), bflo(x.y), bfhi(x.y), bflo(x.z), bfhi(x.z), bflo(x.w), bfhi(x.w)};
                        const f32x4 n0 = *(const LAS f32x4*)(gnp + 8 * i), n1 = *(const LAS f32x4*)(gnp + 8 * i + 4);
                        float gv[8] = {bflo(gw.x), bfhi(gw.x), bflo(gw.y), bfhi(gw.y), bflo(gw.z), bfhi(gw.z), bflo(gw.w), bfhi(gw.w)}; float ov[8];
#pragma unroll
                        for (int e = 0; e < 4; ++e) { ov[e] = v[e] * rs * n0[e] * (gv[e] * sigmoidf(gv[e])); ov[4 + e] = v[4 + e] * rs * n1[e] * (gv[4 + e] * sigmoidf(gv[4 + e])); }
                        u32x4 wv; wv.x = pk2(ov[0], ov[1]); wv.y = pk2(ov[2], ov[3]); wv.z = pk2(ov[4], ov[5]); wv.w = pk2(ov[6], ov[7]);
                        *(u32x4*)(dst + 8 * i) = wv; }
                }
            }
        };
        if (j1first) { J1(); J2(); } else { J2(); J1(); }
        LDS_BARRIER();
    }
#undef GLA_LOADS
#undef GLA_VLOAD
    LDS_BARRIER();
}


#define XB_TMO      128
#define XB_XCNT(j)  (256  + 64 * (j))
#define XB_XSUB(j)  (1280 + 64 * (j))
#define XB_XGEN(j)  (2304 + 64 * (j))
#define XB_TOP      3328
#define XB_TOPGEN   3392
#define XCD_BAR_WORDS 3456
#define XB_SPIN_CAP (1u << 18)

__device__ __forceinline__ unsigned xb_ld(unsigned* p)              { return __hip_atomic_load(p, __ATOMIC_RELAXED, __HIP_MEMORY_SCOPE_AGENT); }
__device__ __forceinline__ unsigned xb_add(unsigned* p, unsigned v) { return __hip_atomic_fetch_add(p, v, __ATOMIC_RELAXED, __HIP_MEMORY_SCOPE_AGENT); }
__device__ __forceinline__ unsigned xb_xcc_id() { return (unsigned)__builtin_amdgcn_s_getreg((3 << 11) | 20) & 0xFu; }
#define XB_SPIN(cond, bar) do { unsigned _sp = 0; while (cond) { __builtin_amdgcn_s_sleep(1); \
    if ((++_sp & 255u) == 0u) { if (xb_ld(&(bar)[XB_TMO])) break; if (_sp > XB_SPIN_CAP) { atomicAdd(&(bar)[XB_TMO], 1u); break; } } } } while (0)

struct XcdBarrier {
    unsigned* bar; unsigned x;
    volatile LAS unsigned* st;
};

__device__ __forceinline__ XcdBarrier xcd_barrier_post(unsigned* bar, volatile LAS unsigned* st) {
    XcdBarrier b; b.bar = bar; b.x = xb_xcc_id(); b.st = st;
    if (threadIdx.x == 0) (void)xb_add(&bar[XB_XCNT(b.x)], 1u);
    return b;
}
__device__ __forceinline__ void xcd_barrier_complete(unsigned* bar, unsigned x, unsigned& nloc, unsigned& nx) {
    const unsigned G = gridDim.x * gridDim.y * gridDim.z;
    unsigned sum, cnt, mine, sp = 0u;
    for (;;) {
        sum = 0u; cnt = 0u; mine = 0u;
#pragma unroll
        for (unsigned j = 0; j < 16; ++j) { const unsigned c = xb_ld(&bar[XB_XCNT(j)]); sum += c; cnt += (c > 0u) ? 1u : 0u; mine = (j == x) ? c : mine; }
        if (sum == G) break;
        __builtin_amdgcn_s_sleep(1);
        if ((++sp & 255u) == 0u) { if (xb_ld(&bar[XB_TMO])) break; if (sp > XB_SPIN_CAP) { atomicAdd(&bar[XB_TMO], 1u); break; } }
    }
    nloc = mine > 0u ? mine : 1u; nx = cnt > 0u ? cnt : 1u;
}

__device__ __forceinline__ void xcd_barrier(const XcdBarrier& b) {
    asm volatile("s_waitcnt vmcnt(0)" ::: "memory");
    __syncthreads();
    if (threadIdx.x == 0) {
        unsigned* bar = b.bar;
        __builtin_amdgcn_s_waitcnt(0);
        unsigned nloc = b.st[0], nx = b.st[1];
        if (nloc == 0u) { xcd_barrier_complete(bar, b.x, nloc, nx); b.st[0] = nloc; b.st[1] = nx; }
        const unsigned old = xb_add(&bar[XB_XSUB(b.x)], 1u);
        const unsigned gen = old / nloc;
        if (old + 1u == (gen + 1u) * nloc) {
            __builtin_amdgcn_fence(__ATOMIC_RELEASE, "agent");
            asm volatile("s_waitcnt vmcnt(0)" ::: "memory");
            const unsigned og = xb_add(&bar[XB_TOP], 1u);
            const unsigned tg = og / nx;
            if (og + 1u == (tg + 1u) * nx) xb_add(&bar[XB_TOPGEN], 1u);
            else XB_SPIN(xb_ld(&bar[XB_TOPGEN]) == tg, bar);
            __builtin_amdgcn_fence(__ATOMIC_ACQUIRE, "agent");
            xb_add(&bar[XB_XGEN(b.x)], 1u);
            asm volatile("s_waitcnt vmcnt(0)" ::: "memory");
        } else {
            XB_SPIN(xb_ld(&bar[XB_XGEN(b.x)]) == gen, bar);
            __builtin_amdgcn_fence(__ATOMIC_ACQUIRE, "agent");
            asm volatile("s_waitcnt vmcnt(0)" ::: "memory");
        }
    }
    __syncthreads();
}

struct Args { const float* in[13]; float* out; unsigned char* ws; };
__global__ void __launch_bounds__(512, 2) fwd_kernel(Args a) {
    extern __shared__ __attribute__((aligned(16))) unsigned char lds_raw[];
    LAS unsigned char* lds = (LAS unsigned char*)lds_raw;
    cg::grid_group grid = cg::this_grid();
    volatile LAS unsigned* MISC = (volatile LAS unsigned*)(lds + MISC_OFF);
    if (threadIdx.x < 4) MISC[threadIdx.x] = 0u;
    __syncthreads();
    unsigned* barw = (unsigned*)(a.ws + WS_BAR);
#define PHASE_IDS() int tid_ = threadIdx.x; asm volatile("" : "+v"(tid_)); const int tid = tid_, lane = tid & 63, wave = __builtin_amdgcn_readfirstlane(tid >> 6), gw = bid * 8 + wave, NGW = G * 8; (void)tid; (void)lane; (void)gw; (void)NGW
    const int G = gridDim.x, bid = blockIdx.x;
    unsigned char* ws = a.ws; unsigned char* dout = (unsigned char*)a.out;
    const float* x = a.in[0];
    float* SS1 = (float*)(ws + WS_SS1); float* SS2 = (float*)(ws + WS_SS2); float* DSEG = (float*)(ws + WS_DSEG); float* ED = (float*)(ws + WS_ED); bf16_t* KT = (bf16_t*)(ws + WS_KT); float* GLOW = (float*)(ws + WS_GLOW);
    bf16_t* WinT = (bf16_t*)(ws + WS_WIN); bf16_t* WpcT = (bf16_t*)(ws + WS_WPA); bf16_t* WoutT = (bf16_t*)(ws + WS_WOUT);
    bf16_t* W1T = (bf16_t*)(ws + WS_W1); bf16_t* W2T = (bf16_t*)(ws + WS_W2);
    bf16_t* HB = (bf16_t*)(ws + WS_HB); bf16_t* OC = (bf16_t*)(ws + WS_OC); bf16_t* GO = (bf16_t*)(dout + DO_GO); bf16_t* GATES = (bf16_t*)(ws + WS_GATES); bf16_t* GQ = (bf16_t*)(ws + WS_GQ); bf16_t* GK = (bf16_t*)(ws + WS_GK);
    bf16_t* QH = (bf16_t*)(ws + WS_QH); bf16_t* KH = (bf16_t*)(ws + WS_KH); bf16_t* HID = (bf16_t*)(ws + WS_HID); float* SLOC = (float*)(ws + WS_SLOC);
    bf16_t* GVT = (bf16_t*)(dout + DO_GVT); bf16_t* VT = (bf16_t*)(ws + WS_VT); bf16_t* MIX = (bf16_t*)(dout + DO_GVT);

    {
        PHASE_IDS();
        for (int i = bid * 512 + tid; i < T; i += G * 512) { SS1[i] = 0.f; SS2[i] = 0.f; }
        if (bid == 0) for (int i = tid; i < XCD_BAR_WORDS; i += 512) __hip_atomic_store(barw + i, 0u, __ATOMIC_RELAXED, __HIP_MEMORY_SCOPE_AGENT);
        LAS float* scr = (LAS float*)(lds + wave * 16384);
        constexpr int I_IN = 16 * (NWIN / 32);
        for (int r = gw; r < I_IN; r += NGW) { const int nb = r % (NWIN / 32), kb = r / (NWIN / 32); transpose_item(a.in[2], D, DIN, WinT, 32 * nb, 64 * kb, 64 * kb, win_src(32 * nb + (lane & 31)), nullptr, scr, lane); }
        const float* gmix = a.in[1];
        for (int m0 = gw * 8; m0 < T; m0 += NGW * 8) {
            f32x4 v[8][4]; float sq[8];
#pragma unroll
            for (int rr = 0; rr < 8; ++rr) { const f32x4* xr = (const f32x4*)(x + (size_t)(m0 + rr) * D) + lane;
#pragma unroll
                for (int j = 0; j < 4; ++j) v[rr][j] = xr[64 * j]; }
#pragma unroll
            for (int rr = 0; rr < 8; ++rr) { float s = 0.f;
#pragma unroll
                for (int j = 0; j < 4; ++j) s += (v[rr][j][0] * v[rr][j][0] + v[rr][j][1] * v[rr][j][1]) + (v[rr][j][2] * v[rr][j][2] + v[rr][j][3] * v[rr][j][3]);
                sq[rr] = rsqrtf(wave_sum(s) * (1.f / D) + EPS); }
#pragma unroll
            for (int j = 0; j < 4; ++j) { const f32x4 gg = ((const f32x4*)gmix)[lane + 64 * j];
#pragma unroll
                for (int rr = 0; rr < 8; ++rr) { u32x2 w; w.x = pk2(v[rr][j][0] * sq[rr] * gg[0], v[rr][j][1] * sq[rr] * gg[1]); w.y = pk2(v[rr][j][2] * sq[rr] * gg[2], v[rr][j][3] * sq[rr] * gg[3]);
                    ((u32x2*)(HB + (size_t)(m0 + rr) * D))[lane + 64 * j] = w; } }
        }
    }
    grid.sync();
    const XcdBarrier xbar = xcd_barrier_post(barw, MISC);

    {
        pg8::Gemm g{HB, WinT, T, NWIN, D}; pg8::StaticOrder S; S.init(T, NWIN, G, bid);
        Epi<E_INPROJ> E{}; E.QH = QH; E.KH = KH; E.GQ = GQ; E.GK = GK; E.GO = GO; E.GATES = GATES; E.VT = VT; E.GVT = GVT; E.GLOW = GLOW;
        pg8::gemm_phase<Epi<E_INPROJ>, pg8::StaticOrder, true, true>(lds, g, S, E);
        const int tb0 = G > 128 ? 128 : 0, tnb = G - tb0;
        if (bid >= tb0) {
            PHASE_IDS();
            LAS float* scr = (LAS float*)(lds + wave * 16384);
            constexpr int I_PA = 8 * 32, I_PB = 16 * 32, I_WO = 16 * 32, I_1 = 16 * 128, I_2 = 64 * 32, NIT = I_PA + I_PB + I_WO + I_1 + I_2;
            for (int it = (bid - tb0) * 8 + wave; it < NIT; it += tnb * 8) {
                int r = it;
                if (r < I_PA) { const int nb = r % 32, kb = r / 32; transpose_item(a.in[6], 1536, D, WpcT, 32 * nb, 64 * kb, 64 * kb, 32 * nb + (lane & 31), nullptr, scr, lane); continue; } r -= I_PA;
                if (r < I_PB) { const int nb = r % 32, kb = r / 32; transpose_item(a.in[7], 1536, D, WpcT, 32 * nb, 64 * kb, 512 + 64 * kb, 32 * nb + (lane & 31), nullptr, scr, lane); continue; } r -= I_PB;
                if (r < I_WO) { const int nb = r % 32, kb = r / 32; transpose_item(a.in[8], D, D, WoutT, 32 * nb, 64 * kb, 64 * kb, 32 * nb + (lane & 31), nullptr, scr, lane); continue; } r -= I_WO;
                if (r < I_1) { const int nb = r % 128, kb = r / 128; transpose_item(a.in[10], D, FF, W1T, 32 * nb, 64 * kb, 64 * kb, 32 * nb + (lane & 31), a.in[9], scr, lane); continue; } r -= I_1;
                { const int nb = r % 32, kb = r / 32; transpose_item(a.in[11], FF, D, W2T, 32 * nb, 64 * kb, 64 * kb, 32 * nb + (lane & 31), nullptr, scr, lane); }
            }
        }
    }
    xcd_barrier(xbar);

    {
        PHASE_IDS();
        for (int u = gw; u < 32 * 64 * 4; u += NGW) gla_prep_unit((LAS bf16_t*)(lds + wave * 10240), GQ, GK, GLOW, a.in[3], a.in[4], KT, ED, u >> 8, (u >> 2) & 63, u & 3, lane);
    }
    xcd_barrier(xbar);

    {
        PHASE_IDS();
        for (int u = bid; u < 32 * 7; u += G) gla_state_block(lds, KT, GVT, ED, SLOC, DSEG, u / 7, u % 7);
        for (int u = gw; u < NB * 8 * 128; u += NGW) sb_attn_unit(QH, KH, VT, OC, u >> 10, (u >> 7) & 7, u & 127, lane);
    }
    xcd_barrier(xbar);

    {
        GlaPtrs gp{GQ, GK, GO, GVT, KT, ED, a.in[5], OC, SLOC, DSEG};
        for (int u = bid; u < 256; u += G) gla_out_unit(lds, gp, u >> 3, u & 7);
    }
    xcd_barrier(xbar);

    {
        pg8::Gemm g{OC, WpcT, T, D, 1536}; pg8::StaticOrder S; S.init(T, D, G, bid);
        Epi<E_PMIX> E{}; E.GATES = GATES; E.MIX = MIX;
        pg8::gemm_phase<Epi<E_PMIX>, pg8::StaticOrder, true, true>(lds, g, S, E);
    }
    xcd_barrier(xbar);

    {
        pg8::Gemm g{MIX, WoutT, T, D, D}; pg8::StaticOrder S; S.init(T, D, G, bid);
        Epi<E_WOUT> E{}; E.XIN = x; E.XB = HB; E.SS = SS1;
        pg8::gemm_phase<Epi<E_WOUT>, pg8::StaticOrder, true, true>(lds, g, S, E);
    }
    xcd_barrier(xbar);

    {
        pg8::Gemm g{HB, W1T, T, FF, D}; pg8::StaticOrder S; S.init(T, FF, G, bid);
        Epi<E_FF1> E{}; E.SS = SS1; E.HID = HID;
        pg8::gemm_phase<Epi<E_FF1>, pg8::StaticOrder, true, true>(lds, g, S, E);
    }
    xcd_barrier(xbar);

    {
        pg8::Gemm g{HID, W2T, T, D, FF}; pg8::StaticOrder S; S.init(T, D, G, bid);
        Epi<E_FF2> E{}; E.XBIN = HB; E.XB = (bf16_t*)(ws + WS_X2B); E.SS = SS2;
        pg8::gemm_phase<Epi<E_FF2>, pg8::StaticOrder, true, true>(lds, g, S, E);
    }
    xcd_barrier(xbar);

    {
        PHASE_IDS();
        const float* gf = a.in[12];
        const bf16_t* X2B = (const bf16_t*)(ws + WS_X2B);
        for (int m0 = gw * 4; m0 < T; m0 += NGW * 4) {
            u32x2 v[4][4]; float rs[4];
#pragma unroll
            for (int rr = 0; rr < 4; ++rr) { const u32x2* xr = (const u32x2*)(X2B + (size_t)(m0 + rr) * D) + lane; rs[rr] = rsqrtf(SS2[m0 + rr] * (1.f / D) + EPS);
#pragma unroll
                for (int j = 0; j < 4; ++j) v[rr][j] = xr[64 * j]; }
#pragma unroll
            for (int j = 0; j < 4; ++j) { const f32x4 gg = ((const f32x4*)gf)[lane + 64 * j];
#pragma unroll
                for (int rr = 0; rr < 4; ++rr) { const f32x4 xv = (f32x4){bflo(v[rr][j].x), bfhi(v[rr][j].x), bflo(v[rr][j].y), bfhi(v[rr][j].y)};
                    ((f32x4*)(a.out + (size_t)(m0 + rr) * D))[lane + 64 * j] = xv * rs[rr] * gg; } }
        }
    }
}

extern "C" void kernel_launch(void* const* d_in, const int* in_sizes, int n_in, void* d_out, int out_size, void* d_ws, size_t ws_size, hipStream_t stream) {
    static int grid = 0;
    if (grid == 0) {
        if (n_in != 13 || in_sizes[0] != T * D || out_size != T * D || ws_size < WS_END) { fprintf(stderr, "kernel_launch: unexpected shapes (n_in %d, in0 %d, out %d, ws %zu)\n", n_in, n_in > 0 ? in_sizes[0] : -1, out_size, ws_size); grid = -1; return; }
        int dev = 0, cus = 0, per_cu = 0;
        hipGetDevice(&dev); hipDeviceGetAttribute(&cus, hipDeviceAttributeMultiprocessorCount, dev);
        if (hipFuncSetAttribute((const void*)fwd_kernel, hipFuncAttributeMaxDynamicSharedMemorySize, LDS_BYTES) != hipSuccess) { fprintf(stderr, "kernel_launch: hipFuncSetAttribute failed\n"); grid = -1; return; }
        if (hipOccupancyMaxActiveBlocksPerMultiprocessor(&per_cu, (const void*)fwd_kernel, 512, LDS_BYTES) != hipSuccess || per_cu < 1) { fprintf(stderr, "kernel_launch: occupancy query gave %d\n", per_cu); per_cu = 1; }
        (void)hipGetLastError();
        grid = cus * 1;
        fprintf(stderr, "kernel_launch: grid %d (cus %d, per_cu %d)\n", grid, cus, per_cu);
    }
    if (grid < 0) return;
    Args a{};
    for (int i = 0; i < 13; ++i) a.in[i] = (const float*)d_in[i];
    a.out = (float*)d_out; a.ws = (unsigned char*)d_ws;
    void* args[] = {&a};
    hipError_t e = hipLaunchCooperativeKernel((const void*)fwd_kernel, dim3(grid), dim3(512), args, LDS_BYTES, stream);
    if (e != hipSuccess) fprintf(stderr, "cooperative launch failed: %s (grid %d)\n", hipGetErrorString(e), grid);
}
```

```cpp
#include <hip/hip_runtime.h>
#include <hip/hip_cooperative_groups.h>
#include <cstdio>
#include <cstdint>
namespace cg = cooperative_groups;
namespace pg8 {
#define PG8_LAS __attribute__((address_space(3)))
typedef unsigned short bf16_t;
typedef short bf16x8 __attribute__((ext_vector_type(8)));
typedef float f32x4 __attribute__((ext_vector_type(4)));
typedef unsigned u32x4 __attribute__((ext_vector_type(4)));
constexpr int BM = 256, BK = 64, HALF = 128, HTB = HALF * BK * 2  , STAGE_BYTES = 8 * HTB, NXCD = 8, WGM = 8;

__host__ __device__ __forceinline__ int lds_byte(int r, int c) { const int st = (r >> 4) * 2 + (c >> 5), rr = r & 15, cc = c & 31, ob = rr * 64 + cc * 2; return st * 1024 + (ob ^ (((ob >> 9) & 1) << 5)); }
__host__ __device__ __forceinline__ void stage_rc(int b, int& R, int& C) { const int st = b / 1024, sb = b % 1024, swz = sb ^ (((sb >> 9) & 1) << 5); R = (st >> 1) * 16 + swz / 64; C = (st & 1) * 32 + (swz % 64) / 2; }
__host__ __device__ __forceinline__ int perm32(int rho) { const int n = rho >> 4, i = rho & 15; return 8 * (i >> 2) + 4 * n + (i & 3); }

struct Unit { int pm, pn; };
struct Gemm { const bf16_t* A; const bf16_t* Bt; int M, N, K; };

struct StaticOrder {
    int nM, nN, nwg, G, c;
    __host__ __device__ void init(int M, int N, int G_, int c_) { nM = M / BM; nN = N / BM; nwg = nM * nN; G = G_; c = c_; }
    __host__ __device__ bool next(int i, Unit& u) const {
        const long L = (long)i * G + c; if (L >= nwg) return false;
        int wgid = (int)L; { const int q = nwg / NXCD, r = nwg % NXCD, xcd = wgid % NXCD, off = wgid / NXCD; wgid = (xcd < r ? xcd * (q + 1) : r * (q + 1) + (xcd - r) * q) + off; }
        const int nig = WGM * nN, gid = wgid / nig, fm = gid * WGM, gsz = (nM - fm) < WGM ? (nM - fm) : WGM;
        u.pm = fm + ((wgid % nig) % gsz); u.pn = (wgid % nig) / gsz; return true;
    }
    __device__ __forceinline__ void a_ready(const Unit&) const {}
    __device__ __forceinline__ void done(const Unit&) const {}
};

__device__ __forceinline__ unsigned cvt_pk_bf16(float lo, float hi) { unsigned r; asm volatile("v_cvt_pk_bf16_f32 %0, %1, %2" : "=v"(r) : "v"(lo), "v"(hi)); return r; }
template <class Epi, class Sched, bool ALIGN_EPI = false, bool SP2 = false>
__device__ __forceinline__ void gemm_phase(PG8_LAS unsigned char* lds, const Gemm g, const Sched& S, const Epi& E) {
    int tid_ = threadIdx.x; asm volatile("" : "+v"(tid_));
    const int tid = tid_, wid = __builtin_amdgcn_readfirstlane(tid >> 6), lane = tid & 63, wr = wid >> 2, wc = wid & 3, fr = lane & 15, fq = lane >> 4;
    const int K = g.K, nt = K / BK;
    unsigned voffA[2], voffB[2];
#pragma unroll
    for (int i = 0; i < 2; ++i) { int R, C; stage_rc(tid * 16 + i * 8192, R, C); const int Rb = Epi::PERM ? ((R & ~31) + perm32(R & 31)) : R;
        voffA[i] = (unsigned)(R * K + C) * 2u; voffB[i] = (unsigned)(Rb * K + C) * 2u; }
    const size_t kstep = (size_t)(BK * 2);
    const size_t hstep = (size_t)HALF * K * 2;
    const size_t tstep = 2 * hstep;
    const unsigned ldsw = (unsigned)wid * 1024u;
    const int aoff = lds_byte(wr * 64 + fr, fq * 8), boff = lds_byte(wc * 32 + fr, fq * 8);
#define PG8_SA(b, h) (((b) * 2 + (h)) * HTB)
#define PG8_SB(b, h) ((4 + (b) * 2 + (h)) * HTB)
#define PG8_STAGE(bufoff, gbase, voff) do { _Pragma("unroll") for (int _i = 0; _i < 2; ++_i) \
        __builtin_amdgcn_global_load_lds((const unsigned*)((const char*)(gbase) + (voff)[_i]), (PG8_LAS unsigned*)(lds + (bufoff) + ldsw + _i * 8192), 16, 0, 0); } while (0)
#define PG8_LDA(dst, b, h) do { _Pragma("unroll") for (int m = 0; m < 4; ++m) _Pragma("unroll") for (int k = 0; k < 2; ++k) dst[m][k] = *(const PG8_LAS bf16x8*)(lds + PG8_SA(b, h) + aoff + m * 2048 + k * 1024); } while (0)
#define PG8_LDB(dst, b, h) do { _Pragma("unroll") for (int n = 0; n < 2; ++n) _Pragma("unroll") for (int k = 0; k < 2; ++k) dst[n][k] = *(const PG8_LAS bf16x8*)(lds + PG8_SB(b, h) + boff + n * 2048 + k * 1024); } while (0)
#define PG8_MMA(ai, bj, At, Bt) do { __builtin_amdgcn_s_setprio(1); _Pragma("unroll") for (int m = 0; m < 4; ++m) _Pragma("unroll") for (int n = 0; n < 2; ++n) _Pragma("unroll") for (int k = 0; k < 2; ++k) \
        acc[ai][bj][m][n] = __builtin_amdgcn_mfma_f32_16x16x32_bf16(Bt[n][k], At[m][k], acc[ai][bj][m][n], 0, 0, 0); __builtin_amdgcn_s_setprio(0); } while (0)
#define PG8_WAIT_V(n) asm volatile("s_waitcnt vmcnt(" #n ")" ::: "memory")
#define PG8_WAIT_L(n) asm volatile("s_waitcnt lgkmcnt(" #n ")" ::: "memory")
#define PG8_BAR __builtin_amdgcn_s_barrier()
#define PG8_SCHED __builtin_amdgcn_sched_barrier(0)
    Unit cur, nxt; int ui = 0;
    if (!S.next(0, cur)) return;
    f32x4 acc[2][2][4][2];
#pragma unroll
    for (int a = 0; a < 2; ++a)
#pragma unroll
        for (int b = 0; b < 2; ++b)
#pragma unroll
            for (int m = 0; m < 4; ++m)
#pragma unroll
                for (int n = 0; n < 2; ++n) acc[a][b][m][n] = (f32x4){0.f, 0.f, 0.f, 0.f};
    bf16x8 At[4][2], B0[2][2], B1[2][2];
    const char* cA = (const char*)g.A + (size_t)cur.pm * tstep; const char* cB = (const char*)g.Bt + (size_t)cur.pn * tstep;
    S.a_ready(cur);
    if constexpr (SP2) {
        PG8_STAGE(PG8_SB(0, 0), cB, voffB); PG8_STAGE(PG8_SB(0, 1), cB + hstep, voffB); PG8_STAGE(PG8_SA(0, 0), cA, voffA); PG8_STAGE(PG8_SA(0, 1), cA + hstep, voffA);
        if (wr == 1) PG8_BAR;
        PG8_WAIT_V(2); PG8_BAR;
        PG8_STAGE(PG8_SB(1, 0), cB + kstep, voffB); PG8_STAGE(PG8_SA(1, 0), cA + kstep, voffA); PG8_STAGE(PG8_SB(1, 1), cB + hstep + kstep, voffB);
        PG8_WAIT_V(6); PG8_BAR;
    } else {
        PG8_STAGE(PG8_SB(0, 0), cB, voffB); PG8_STAGE(PG8_SA(0, 0), cA, voffA); PG8_STAGE(PG8_SB(0, 1), cB + hstep, voffB); PG8_STAGE(PG8_SA(0, 1), cA + hstep, voffA);
        if (wr == 1) PG8_BAR;
        PG8_WAIT_V(4); PG8_BAR;
        PG8_STAGE(PG8_SB(1, 0), cB + kstep, voffB); PG8_STAGE(PG8_SA(1, 0), cA + kstep, voffA); PG8_STAGE(PG8_SB(1, 1), cB + hstep + kstep, voffB);
        PG8_WAIT_V(6); PG8_BAR;
    }
    for (;;) {
        const bool has_next = S.next(ui + 1, nxt);
        const char* nA = has_next ? (const char*)g.A + (size_t)nxt.pm * tstep : cA; const char* nB = has_next ? (const char*)g.Bt + (size_t)nxt.pn * tstep : cB;
        for (int t = 0; t < nt; t += 2) {
            if constexpr (Epi::MIDK > 0) { if (t == Epi::MIDK) E.mid(acc, cur, wr, wc, fr, fq); }
            const bool last = (t == nt - 2);
            const char* a1 = cA + (size_t)(t + 1) * kstep;
            const char* a2 = last ? nA : cA + (size_t)(t + 2) * kstep; const char* b2 = last ? nB : cB + (size_t)(t + 2) * kstep;
            const char* a3 = a2 + kstep; const char* b3 = b2 + kstep;
            if (last && has_next) S.a_ready(nxt);
            if constexpr (SP2) {
            PG8_LDB(B0, 0, 0); PG8_LDB(B1, 0, 1); PG8_SCHED; PG8_LDA(At, 0, 0); PG8_STAGE(PG8_SA(1, 1), a1 + hstep, voffA);
            PG8_WAIT_V(8); PG8_WAIT_L(0); PG8_BAR; PG8_MMA(0, 0, At, B0); PG8_MMA(0, 1, At, B1); PG8_BAR; PG8_SCHED;
            PG8_LDA(At, 0, 1); PG8_STAGE(PG8_SB(0, 0), b2, voffB); PG8_STAGE(PG8_SB(0, 1), b2 + hstep, voffB); PG8_STAGE(PG8_SA(0, 0), a2, voffA);
            PG8_WAIT_V(8); PG8_WAIT_L(0); PG8_BAR; PG8_MMA(1, 0, At, B0); PG8_MMA(1, 1, At, B1); PG8_BAR; PG8_SCHED;
            PG8_LDB(B0, 1, 0); PG8_LDB(B1, 1, 1); PG8_SCHED; PG8_LDA(At, 1, 0); PG8_STAGE(PG8_SA(0, 1), a2 + hstep, voffA);
            PG8_WAIT_V(8); PG8_WAIT_L(0); PG8_BAR; PG8_MMA(0, 0, At, B0); PG8_MMA(0, 1, At, B1); PG8_BAR; PG8_SCHED;
            PG8_LDA(At, 1, 1); PG8_STAGE(PG8_SB(1, 0), b3, voffB); PG8_STAGE(PG8_SB(1, 1), b3 + hstep, voffB); PG8_STAGE(PG8_SA(1, 0), a3, voffA);
            PG8_WAIT_V(8); PG8_WAIT_L(0); PG8_BAR; PG8_MMA(1, 0, At, B0); PG8_MMA(1, 1, At, B1); PG8_BAR; PG8_SCHED;
            } else {
            PG8_LDB(B0, 0, 0); PG8_SCHED; PG8_LDA(At, 0, 0); PG8_STAGE(PG8_SA(1, 1), a1 + hstep, voffA);
            PG8_WAIT_L(8); PG8_BAR; PG8_WAIT_L(0); PG8_MMA(0, 0, At, B0); PG8_BAR; PG8_SCHED;
            PG8_LDB(B1, 0, 1); PG8_STAGE(PG8_SB(0, 0), b2, voffB);
            PG8_BAR; PG8_WAIT_L(0); PG8_MMA(0, 1, At, B1); PG8_BAR;
            PG8_LDA(At, 0, 1); PG8_STAGE(PG8_SA(0, 0), a2, voffA);
            PG8_BAR; PG8_WAIT_L(0); PG8_MMA(1, 0, At, B0); PG8_BAR; PG8_SCHED;
            PG8_STAGE(PG8_SB(0, 1), b2 + hstep, voffB);
            PG8_WAIT_V(6); PG8_BAR; PG8_MMA(1, 1, At, B1); PG8_BAR;
            PG8_LDB(B0, 1, 0); PG8_SCHED; PG8_LDA(At, 1, 0); PG8_STAGE(PG8_SA(0, 1), a2 + hstep, voffA);
            PG8_WAIT_L(8); PG8_BAR; PG8_WAIT_L(0); PG8_MMA(0, 0, At, B0); PG8_BAR; PG8_SCHED;
            PG8_LDB(B1, 1, 1); PG8_STAGE(PG8_SB(1, 0), b3, voffB);
            PG8_BAR; PG8_WAIT_L(0); PG8_MMA(0, 1, At, B1); PG8_BAR;
            PG8_LDA(At, 1, 1); PG8_STAGE(PG8_SA(1, 0), a3, voffA);
            PG8_BAR; PG8_WAIT_L(0); PG8_MMA(1, 0, At, B0); PG8_BAR; PG8_SCHED;
            PG8_STAGE(PG8_SB(1, 1), b3 + hstep, voffB);
            PG8_WAIT_V(6); PG8_BAR; PG8_MMA(1, 1, At, B1); PG8_BAR;
            }
        }
        if constexpr (ALIGN_EPI) { if (wr == 0) PG8_BAR; }
        if constexpr (!Epi::AFTER_DRAIN) { E(acc, cur, wr, wc, fr, fq); S.done(cur); }
        if (!has_next) break;
#pragma unroll
        for (int a = 0; a < 2; ++a)
#pragma unroll
            for (int b = 0; b < 2; ++b)
#pragma unroll
                for (int m = 0; m < 4; ++m)
#pragma unroll
                    for (int n = 0; n < 2; ++n) acc[a][b][m][n] = (f32x4){0.f, 0.f, 0.f, 0.f};
        cur = nxt; cA = nA; cB = nB; ++ui;
        if constexpr (ALIGN_EPI) { if (wr == 1) PG8_BAR; }
    }
    PG8_WAIT_V(0);
    if constexpr (!ALIGN_EPI) { if (wr == 0) PG8_BAR; }
    PG8_BAR;
    if constexpr (Epi::AFTER_DRAIN) { E.fused(acc, cur, wr, wc, fr, fq, lds, wid, lane); S.done(cur); }
#undef PG8_SA
#undef PG8_SB
#undef PG8_STAGE
#undef PG8_LDA
#undef PG8_LDB
#undef PG8_MMA
#undef PG8_WAIT_V
#undef PG8_WAIT_L
#undef PG8_BAR
#undef PG8_SCHED
}
}

#define LAS __attribute__((address_space(3)))
typedef unsigned short bf16_t;
typedef short bf16x8 __attribute__((ext_vector_type(8)));
typedef float f32x4 __attribute__((ext_vector_type(4)));
typedef float f32x16 __attribute__((ext_vector_type(16)));
typedef unsigned u32x4 __attribute__((ext_vector_type(4)));
typedef unsigned u32x2 __attribute__((ext_vector_type(2)));

constexpr int NB = 8, SEQ = 4096, T = NB * SEQ, D = 1024, FF = 4096, DIN = 6672;
constexpr int NWIN = 6912;
constexpr float EPS = 1e-6f;
constexpr size_t MiB = 1u << 20;
constexpr size_t WS_SS1 = 0, WS_SS2 = 128 * 1024, WS_DSEG = 256 * 1024, WS_ED = 3 * MiB, WS_KT = 420 * MiB;
constexpr size_t WS_GLOW = 1 * MiB, WS_WIN = 4 * MiB, WS_WPA = 18 * MiB, WS_WPB = 19 * MiB, WS_WOUT = 21 * MiB, WS_W1 = 23 * MiB, WS_W2 = 31 * MiB;
constexpr size_t WS_X2B = 104 * MiB;
constexpr size_t WS_HB = 40 * MiB, WS_OC = 40 * MiB, WS_GATES = 136 * MiB, WS_GQ = 264 * MiB, WS_GK = 296 * MiB, WS_QH = 328 * MiB, WS_KH = 360 * MiB, WS_SLOC = 392 * MiB, WS_VT = 452 * MiB, WS_HID = 232 * MiB, WS_END = 488 * MiB;
constexpr size_t DO_GVT = 0, DO_GO = 64 * MiB;
constexpr int LDS_BYTES = 147456, MISC_OFF = LDS_BYTES - 64;
constexpr size_t WS_BAR = 512 * 1024;

__device__ __forceinline__ float bf2f(unsigned short v) { return __uint_as_float((unsigned)v << 16); }
__device__ __forceinline__ float bflo(unsigned v) { return __uint_as_float(v << 16); }
__device__ __forceinline__ float bfhi(unsigned v) { return __uint_as_float(v & 0xffff0000u); }
__device__ __forceinline__ unsigned pk2(float lo, float hi) { return pg8::cvt_pk_bf16(lo, hi); }
__device__ __forceinline__ unsigned short f2bf(float f) { return (unsigned short)(pg8::cvt_pk_bf16(f, 0.f) & 0xffffu); }
typedef float f32x2_t __attribute__((ext_vector_type(2))); typedef __bf16 bf16x2_t __attribute__((ext_vector_type(2)));
__device__ __forceinline__ unsigned pk2_v(float lo, float hi) { f32x2_t v = {lo, hi}; bf16x2_t b = __builtin_convertvector(v, bf16x2_t); return __builtin_bit_cast(unsigned, b); }
__device__ __forceinline__ unsigned short f2bf_v(float f) { f32x2_t v = {f, 0.f}; bf16x2_t b = __builtin_convertvector(v, bf16x2_t); return (unsigned short)(__builtin_bit_cast(unsigned, b) & 0xffffu); }
__device__ __forceinline__ float fexp(float x) { return __expf(x); }
__device__ __forceinline__ float softplus(float z) { return fmaxf(z, 0.f) + __logf(1.f + __expf(-fabsf(z))); }
__device__ __forceinline__ float sigmoidf(float x) { return __builtin_amdgcn_rcpf(1.f + __expf(-x)); }
__device__ __forceinline__ float wave_sum(float v) {
#pragma unroll
    for (int o = 1; o < 64; o <<= 1) v += __shfl_xor(v, o);
    return v;
}
__device__ __forceinline__ bf16x8 pack8(float a0, float a1, float a2, float a3, float a4, float a5, float a6, float a7) {
    u32x4 w; w.x = pk2(a0, a1); w.y = pk2(a2, a3); w.z = pk2(a4, a5); w.w = pk2(a6, a7); return __builtin_bit_cast(bf16x8, w);
}
#define LDS_WAIT() asm volatile("s_waitcnt lgkmcnt(0)" ::: "memory")
#define LDS_BARRIER() do { asm volatile("s_waitcnt lgkmcnt(0)" ::: "memory"); __builtin_amdgcn_s_barrier(); asm volatile("" ::: "memory"); } while (0)

enum { E_INPROJ = 0, E_PMIX = 1, E_WOUT = 3, E_FF1 = 4, E_FF2 = 5 };
template <int MODE> struct Epi {
    static constexpr bool PERM = (MODE == E_INPROJ || MODE == E_PMIX || MODE == E_FF1), AFTER_DRAIN = false;
    static constexpr int MIDK = (MODE == E_PMIX) ? 8 : 0;
    bf16_t* QH; bf16_t* KH; bf16_t* GQ; bf16_t* GK; bf16_t* GO; bf16_t* GATES; bf16_t* VT; bf16_t* GVT; float* GLOW;
    bf16_t* MIX;
    const float* XIN; const bf16_t* XBIN; bf16_t* XB; float* SS;
    bf16_t* HID;
    static __device__ __forceinline__ float sigB(float g) { return __builtin_amdgcn_rcpf(1.f + fminf(__expf(-g), 1e20f)); }
    static __device__ __forceinline__ float ratioAB(float ga, float gb) { return (1.f + fminf(__expf(-gb), 1e20f)) * __builtin_amdgcn_rcpf(1.f + __expf(-ga)); }
    __device__ __forceinline__ void mid(f32x4 (&acc)[2][2][4][2], const pg8::Unit& u, int wr, int wc, int fr, int fq) const {
        if constexpr (MODE == E_PMIX) {
            int fr_ = fr, fq_ = fq; asm volatile("" : "+v"(fr_), "+v"(fq_));
            const int row0 = u.pm * 256 + wr * 64 + fr_, col0 = u.pn * 256 + wc * 32 + 8 * fq_;
#pragma unroll
            for (int ai = 0; ai < 2; ++ai)
#pragma unroll
                for (int m = 0; m < 4; ++m) { const size_t r = (size_t)(row0 + ai * 128 + m * 16);
#pragma unroll
                    for (int bj = 0; bj < 2; ++bj) {
                        const u32x4 ga = *(const u32x4*)(GATES + r * 2048 + col0 + bj * 128), gb = *(const u32x4*)(GATES + r * 2048 + 1024 + col0 + bj * 128);
                        f32x4 r0, r1;
                        r0[0] = ratioAB(bflo(ga.x), bflo(gb.x)); r0[1] = ratioAB(bfhi(ga.x), bfhi(gb.x)); r0[2] = ratioAB(bflo(ga.y), bflo(gb.y)); r0[3] = ratioAB(bfhi(ga.y), bfhi(gb.y));
                        r1[0] = ratioAB(bflo(ga.z), bflo(gb.z)); r1[1] = ratioAB(bfhi(ga.z), bfhi(gb.z)); r1[2] = ratioAB(bflo(ga.w), bflo(gb.w)); r1[3] = ratioAB(bfhi(ga.w), bfhi(gb.w));
                        acc[ai][bj][m][0] *= r0; acc[ai][bj][m][1] *= r1; }
                    if (m & 1) asm volatile("" ::: "memory"); }
        }
    }
    __device__ __forceinline__ void operator()(const f32x4 (&acc)[2][2][4][2], const pg8::Unit& u, int wr, int wc, int fr, int fq) const {
        const int row0 = u.pm * 256 + wr * 64 + fr;
        if constexpr (MODE == E_INPROJ) {
            if (u.pn < 20) {
                const int b = u.pm >> 4, s0 = (u.pm & 15) * 256 + wr * 64 + fr;
                bf16_t* base; size_t off0, rstride, bjstride;
                if (u.pn < 4) { base = (u.pn < 2) ? QH : KH;
                    off0 = ((size_t)(b * 8 + (u.pn & 1) * 4 + (wc >> 1)) * SEQ + s0) * 64 + (wc & 1) * 32 + 8 * fq; rstride = 64; bjstride = (size_t)2 * SEQ * 64; }
                else if (u.pn < 8) { base = (u.pn < 6) ? GQ : GK;
                    off0 = ((size_t)(b * 4 + (u.pn & 1) * 2) * SEQ + s0) * 128 + wc * 32 + 8 * fq; rstride = 128; bjstride = (size_t)SEQ * 128; }
                else if (u.pn < 12) { base = GO; off0 = (size_t)row0 * 1024 + (u.pn - 8) * 256 + wc * 32 + 8 * fq; rstride = 1024; bjstride = 128; }
                else { base = GATES; off0 = (size_t)row0 * 2048 + (u.pn - 12) * 256 + wc * 32 + 8 * fq; rstride = 2048; bjstride = 128; }
#pragma unroll
                for (int ai = 0; ai < 2; ++ai)
#pragma unroll
                    for (int m = 0; m < 4; ++m) { bf16_t* rowp = base + off0 + (size_t)(ai * 128 + m * 16) * rstride;
#pragma unroll
                        for (int bj = 0; bj < 2; ++bj) { const f32x4 v0 = acc[ai][bj][m][0], v1 = acc[ai][bj][m][1];
                            u32x4 w; w.x = pk2(v0[0], v0[1]); w.y = pk2(v0[2], v0[3]); w.z = pk2(v1[0], v1[1]); w.w = pk2(v1[2], v1[3]);
                            *(u32x4*)(rowp + bj * bjstride) = w; } }
            } else if (u.pn < 26) {
                const int b = u.pm >> 4, ck0 = (u.pm & 15) * 4 + wr;
                const int ncol = (u.pn < 22) ? 512 : 1024;
                bf16_t* dst = (u.pn < 22) ? VT : GVT;
                dst += (((size_t)(b * 64 + ck0) * ncol) + ((u.pn < 22) ? (u.pn - 20) : (u.pn - 22)) * 256 + wc * 32 + 8 * fq) * 64 + fr;
#pragma unroll
                for (int ai = 0; ai < 2; ++ai)
#pragma unroll
                    for (int m = 0; m < 4; ++m)
#pragma unroll
                        for (int bj = 0; bj < 2; ++bj)
#pragma unroll
                            for (int n = 0; n < 2; ++n) { const f32x4 v = acc[ai][bj][m][n];
#pragma unroll
                                for (int e = 0; e < 4; ++e) dst[((size_t)(2 * ai) * ncol + bj * 128 + 4 * n + e) * 64 + m * 16] = f2bf(v[e]); }
            } else {
                if (wc == 0 && fq < 2) {
#pragma unroll
                    for (int ai = 0; ai < 2; ++ai)
#pragma unroll
                        for (int m = 0; m < 4; ++m)
#pragma unroll
                            for (int n = 0; n < 2; ++n) *(f32x4*)(GLOW + (size_t)(row0 + ai * 128 + m * 16) * 16 + 8 * fq + 4 * n) = acc[ai][0][m][n];
                }
            }
        } else if constexpr (MODE == E_PMIX) {
            const int col0 = u.pn * 256 + wc * 32 + 8 * fq;
#pragma unroll
            for (int ai = 0; ai < 2; ++ai)
#pragma unroll
                for (int m = 0; m < 4; ++m) { const size_t r = (size_t)(row0 + ai * 128 + m * 16);
#pragma unroll
                    for (int bj = 0; bj < 2; ++bj) {
                        const u32x4 g = *(const u32x4*)(GATES + r * 2048 + 1024 + col0 + bj * 128);
                        const f32x4 v0 = acc[ai][bj][m][0], v1 = acc[ai][bj][m][1];
                        float o[8];
                        o[0] = v0[0] * sigB(bflo(g.x)); o[1] = v0[1] * sigB(bfhi(g.x)); o[2] = v0[2] * sigB(bflo(g.y)); o[3] = v0[3] * sigB(bfhi(g.y));
                        o[4] = v1[0] * sigB(bflo(g.z)); o[5] = v1[1] * sigB(bfhi(g.z)); o[6] = v1[2] * sigB(bflo(g.w)); o[7] = v1[3] * sigB(bfhi(g.w));
                        u32x4 w; w.x = pk2(o[0], o[1]); w.y = pk2(o[2], o[3]); w.z = pk2(o[4], o[5]); w.w = pk2(o[6], o[7]);
                        *(u32x4*)(MIX + r * D + col0 + bj * 128) = w; } }
        } else if constexpr (MODE == E_WOUT || MODE == E_FF2) {
            const int col0 = u.pn * 256 + wc * 32 + 4 * fq;
#pragma unroll
            for (int ai = 0; ai < 2; ++ai)
#pragma unroll
                for (int m = 0; m < 4; ++m) { const size_t r = (size_t)(row0 + ai * 128 + m * 16); float ss = 0.f;
#pragma unroll
                    for (int bj = 0; bj < 2; ++bj)
#pragma unroll
                        for (int n = 0; n < 2; ++n) { const size_t off = r * D + col0 + bj * 128 + n * 16;
                            f32x4 xv;
                            if constexpr (MODE == E_WOUT) xv = *(const f32x4*)(XIN + off);
                            else { const u32x2 xb = *(const u32x2*)(XBIN + off); xv = (f32x4){bflo(xb.x), bfhi(xb.x), bflo(xb.y), bfhi(xb.y)}; }
                            const f32x4 o = xv + acc[ai][bj][m][n];
                            ss += (o[0] * o[0] + o[1] * o[1]) + (o[2] * o[2] + o[3] * o[3]);
                            u32x2 w; w.x = pk2(o[0], o[1]); w.y = pk2(o[2], o[3]); *(u32x2*)(XB + off) = w; }
                    ss += __shfl_xor(ss, 16); ss += __shfl_xor(ss, 32);
                    if (fq == 0) unsafeAtomicAdd(SS + r, ss); }
        } else {
            const int col0 = u.pn * 256 + wc * 32 + 8 * fq;
#pragma unroll
            for (int ai = 0; ai < 2; ++ai)
#pragma unroll
                for (int m = 0; m < 4; ++m) { const size_t r = (size_t)(row0 + ai * 128 + m * 16);
                    const float rs = rsqrtf(SS[r] * (1.f / D) + EPS);
#pragma unroll
                    for (int bj = 0; bj < 2; ++bj) { f32x4 v0 = acc[ai][bj][m][0] * rs, v1 = acc[ai][bj][m][1] * rs;
#pragma unroll
                        for (int e = 0; e < 4; ++e) { const float a = fmaxf(v0[e], 0.f), c = fmaxf(v1[e], 0.f); v0[e] = a * a; v1[e] = c * c; }
                        u32x4 w; w.x = pk2(v0[0], v0[1]); w.y = pk2(v0[2], v0[3]); w.z = pk2(v1[0], v1[1]); w.w = pk2(v1[2], v1[3]);
                        *(u32x4*)(HID + r * FF + col0 + bj * 128) = w; } }
        }
    }
};

struct RevOrder : pg8::StaticOrder {
    __host__ __device__ bool next(int i, pg8::Unit& u) const { const bool r = pg8::StaticOrder::next(i, u); u.pm = nM - 1 - u.pm; return r; }
};
__device__ __forceinline__ int win_src(int n) {
    if (n < 1024) return n;
    if (n < 2048) return n + 512;
    if (n < 3072) return n + 1536;
    if (n < 5120) return n + 1552;
    if (n < 5632) return n - 4096;
    if (n < 6656) return n - 3072;
    if (n < 6672) return n - 2048;
    return -1;
}
__device__ __forceinline__ void transpose_item(const float* W, int K, int Nsrc, bf16_t* WT, int n0, int k0, int kdst, int srccol, const float* kscale, LAS float* scr, int lane) {
#pragma unroll 8
    for (int i = 0; i < 32; ++i) { const int kk = 2 * i + (lane >> 5); float v = 0.f;
        if (srccol >= 0) v = W[(size_t)(k0 + kk) * Nsrc + srccol];
        if (kscale) v *= kscale[k0 + kk];
        scr[kk * 33 + (lane & 31)] = v; }
    LDS_WAIT();
    const int c = lane & 7;
#pragma unroll
    for (int j = 0; j < 4; ++j) { const int n = (lane >> 3) + 8 * j; const LAS float* s = scr + (8 * c) * 33 + n;
        u32x4 o; o.x = pk2(s[0 * 33], s[1 * 33]); o.y = pk2(s[2 * 33], s[3 * 33]); o.z = pk2(s[4 * 33], s[5 * 33]); o.w = pk2(s[6 * 33], s[7 * 33]);
        *(u32x4*)(WT + (size_t)(n0 + n) * K + kdst + 8 * c) = o; }
    LDS_WAIT();
}

__device__ __forceinline__ void sb_tile(const bf16x8 (&kf)[4], const bf16x8 (&va)[4], const bf16x8 (&qf)[4], f32x16& o0, f32x16& o1, float& carry, bool diag, int l32, int hi) {
    f32x16 z;
#pragma unroll
    for (int r = 0; r < 16; ++r) z[r] = 0.f;
#pragma unroll
    for (int st = 0; st < 4; ++st) z = __builtin_amdgcn_mfma_f32_32x32x16_bf16(kf[st], qf[st], z, 0, 0, 0);
    float wv[16]; float run = 1.f;
#pragma unroll
    for (int r = 15; r >= 0; --r) {
        const float zz = z[r] * 0.125f, tt = __expf(-fabsf(zz)), rr = __builtin_amdgcn_rcpf(1.f + tt), b2 = tt * rr;
        float beta = zz >= 0.f ? rr : b2, fail = zz >= 0.f ? b2 : rr;
        if (diag) { const bool valid = (16 * hi + r < l32); beta = valid ? beta : 0.f; fail = valid ? fail : 1.f; }
        wv[r] = beta * run; run *= fail;
    }
    const float other = __shfl_xor(run, 32);
    const float add = carry * (hi == 0 ? other : 1.f);
#pragma unroll
    for (int r = 0; r < 16; ++r) wv[r] *= add;
    carry *= run * other;
    const bf16x8 pb0 = pack8(wv[0], wv[1], wv[2], wv[3], wv[4], wv[5], wv[6], wv[7]);
    const bf16x8 pb1 = pack8(wv[8], wv[9], wv[10], wv[11], wv[12], wv[13], wv[14], wv[15]);
    o0 = __builtin_amdgcn_mfma_f32_32x32x16_bf16(va[0], pb0, o0, 0, 0, 0);
    o0 = __builtin_amdgcn_mfma_f32_32x32x16_bf16(va[1], pb1, o0, 0, 0, 0);
    o1 = __builtin_amdgcn_mfma_f32_32x32x16_bf16(va[2], pb0, o1, 0, 0, 0);
    o1 = __builtin_amdgcn_mfma_f32_32x32x16_bf16(va[3], pb1, o1, 0, 0, 0);
}
__device__ __forceinline__ void sb_attn_unit(const bf16_t* __restrict__ QH, const bf16_t* __restrict__ KH, const bf16_t* __restrict__ VT, bf16_t* __restrict__ OSB, int b, int h, int qt, int lane_) {
    int lane = lane_; asm volatile("" : "+v"(lane));
    const int l32 = lane & 31, hi = lane >> 5, t0 = qt * 32;
    const size_t rowb = (size_t)b * SEQ;
    const size_t hb = (size_t)(b * 8 + h) * SEQ;
    const bf16_t* qrow = QH + (hb + t0 + l32) * 64 + 8 * hi;
    bf16x8 qf[4];
#pragma unroll
    for (int st = 0; st < 4; ++st) qf[st] = *(const bf16x8*)(qrow + 16 * st);
    f32x16 o0, o1;
#pragma unroll
    for (int r = 0; r < 16; ++r) { o0[r] = 0.f; o1[r] = 0.f; }
    float carry = 1.f;
    const int kperm = 16 * ((l32 >> 2) & 1) + (l32 & 3) + 4 * (l32 >> 3);
    bf16x8 k0[4], v0[4], k1[4], v1[4], k2[4], v2[4];
#define SB_LOAD(KF, VA, s0_) do { const bf16_t* krow_ = KH + (hb + (s0_) + kperm) * 64 + 8 * hi; \
        const bf16_t* vb_ = VT + (((size_t)(b * 64 + ((s0_) >> 6)) * 512 + h * 64 + l32) * 64 + ((s0_) & 63) + 16 * hi); \
        _Pragma("unroll") for (int st = 0; st < 4; ++st) KF[st] = *(const bf16x8*)(krow_ + 16 * st); \
        VA[0] = *(const bf16x8*)(vb_); VA[1] = *(const bf16x8*)(vb_ + 8); VA[2] = *(const bf16x8*)(vb_ + 32 * 64); VA[3] = *(const bf16x8*)(vb_ + 32 * 64 + 8); } while (0)
#define SB_STEP(KC, VC, KP, VP, DIAG) { { const int sp_ = s0 >= 64 ? s0 - 64 : 0; SB_LOAD(KP, VP, sp_); }     \
        sb_tile(KC, VC, qf, o0, o1, carry, DIAG, l32, hi); if (s0 < 32 || __all(carry == 0.f)) break; s0 -= 32; }
    SB_LOAD(k0, v0, t0);
    { const int sp_ = t0 >= 32 ? t0 - 32 : 0; SB_LOAD(k1, v1, sp_); }
    for (int s0 = t0; ; ) {
        SB_STEP(k0, v0, k2, v2, s0 == t0)
        SB_STEP(k1, v1, k0, v0, false)
        SB_STEP(k2, v2, k1, v1, false)
    }
#undef SB_STEP
#undef SB_LOAD
    bf16_t* orow = OSB + (rowb + t0 + l32) * 1536 + h * 64 + 4 * hi;
#pragma unroll
    for (int g = 0; g < 4; ++g) {
        u32x2 w0, w1; w0.x = pk2_v(o0[4 * g], o0[4 * g + 1]); w0.y = pk2_v(o0[4 * g + 2], o0[4 * g + 3]); w1.x = pk2_v(o1[4 * g], o1[4 * g + 1]); w1.y = pk2_v(o1[4 * g + 2], o1[4 * g + 3]);
        *(u32x2*)(orow + 8 * g) = w0; *(u32x2*)(orow + 32 + 8 * g) = w1;
    }
}

__device__ __forceinline__ void split_hl(float a, float b, unsigned& h, unsigned& l) { h = pk2(a, b); l = pk2(a - bflo(h), b - bfhi(h)); }
__device__ __forceinline__ void split8(float v0, float v1, float v2, float v3, float v4, float v5, float v6, float v7, bf16x8& hv, bf16x8& lv) {
    unsigned h0, h1, h2, h3, l0, l1, l2, l3; split_hl(v0, v1, h0, l0); split_hl(v2, v3, h1, l1); split_hl(v4, v5, h2, l2); split_hl(v6, v7, h3, l3);
    u32x4 ph, pl; ph.x = h0; ph.y = h1; ph.z = h2; ph.w = h3; pl.x = l0; pl.y = l1; pl.z = l2; pl.w = l3; hv = __builtin_bit_cast(bf16x8, ph); lv = __builtin_bit_cast(bf16x8, pl); }
__device__ __forceinline__ void gla_prep_unit(LAS bf16_t* lq, bf16_t* GQ, bf16_t* GK, const float* __restrict__ GLOW, const float* __restrict__ Wgu, const float* __restrict__ bgu, bf16_t* __restrict__ KT, float* __restrict__ ED, int bh, int chunk, int cb, int lane_) {
    int lane = lane_; asm volatile("" : "+v"(lane));
    const int b = bh >> 2, h = bh & 3, l32 = lane & 31, hi = lane >> 5, c = 32 * cb + l32;
    const size_t tok0 = (size_t)b * SEQ + chunk * 64;
    bf16x8 wh, wl;
    { float wv[8];
#pragma unroll
      for (int j = 0; j < 8; ++j) wv[j] = Wgu[(8 * hi + j) * 512 + h * 128 + c];
      split8(wv[0], wv[1], wv[2], wv[3], wv[4], wv[5], wv[6], wv[7], wh, wl); }
    const float bg = bgu[h * 128 + c];
    const size_t tile = ((size_t)bh * 64 + chunk) * 8192;
    bf16_t* pt = KT + tile + c * 64 + 4 * hi;
    LAS bf16_t* lk = lq + 64 * 40;
    u32x4 gq4[4], gk4[4];
#pragma unroll
    for (int j = 0; j < 4; ++j) { const int idx = lane + 64 * j, row = idx >> 2, part = idx & 3; const size_t o_ = tile + (size_t)row * 128 + cb * 32 + part * 8;
        gq4[j] = *(const u32x4*)(GQ + o_); gk4[j] = *(const u32x4*)(GK + o_); }
    bf16x8 ltri[2], lone;
#pragma unroll
    for (int op = 0; op < 2; ++op)
#pragma unroll
        for (int j = 0; j < 8; ++j) { const int r = 8 * op + j, tp = (r & 3) + 8 * (r >> 2) + 4 * hi; ltri[op][j] = (tp <= l32) ? (short)0x3F80 : (short)0; }
#pragma unroll
    for (int j = 0; j < 8; ++j) lone[j] = (short)0x3F80;
    f32x16 la[2];
#pragma unroll
    for (int tb = 0; tb < 2; ++tb) {
        const float* gp = GLOW + (tok0 + 32 * tb + l32) * 16 + 8 * hi;
        const f32x4 g0 = *(const f32x4*)gp, g1 = *(const f32x4*)(gp + 4);
        bf16x8 ahv, alv; split8(g0[0], g0[1], g0[2], g0[3], g1[0], g1[1], g1[2], g1[3], ahv, alv);
        f32x16 x;
#pragma unroll
        for (int r = 0; r < 16; ++r) x[r] = bg;
        x = __builtin_amdgcn_mfma_f32_32x32x16_bf16(alv, wh, x, 0, 0, 0);
        x = __builtin_amdgcn_mfma_f32_32x32x16_bf16(ahv, wl, x, 0, 0, 0);
        x = __builtin_amdgcn_mfma_f32_32x32x16_bf16(ahv, wh, x, 0, 0, 0);
#pragma unroll
        for (int r = 0; r < 16; ++r) la[tb][r] = -softplus(-x[r]) * (1.f / 16.f);
    }
    bf16x8 bhv[2][2], blv[2][2];
#pragma unroll
    for (int tb = 0; tb < 2; ++tb)
#pragma unroll
        for (int op = 0; op < 2; ++op) split8(la[tb][8 * op], la[tb][8 * op + 1], la[tb][8 * op + 2], la[tb][8 * op + 3], la[tb][8 * op + 4], la[tb][8 * op + 5], la[tb][8 * op + 6], la[tb][8 * op + 7], bhv[tb][op], blv[tb][op]);
    f32x16 bc[2];
#pragma unroll
    for (int tb = 0; tb < 2; ++tb) {
#pragma unroll
        for (int r = 0; r < 16; ++r) bc[tb][r] = 0.f;
#pragma unroll
        for (int op = 0; op < 2; ++op) {
            bc[tb] = __builtin_amdgcn_mfma_f32_32x32x16_bf16(ltri[op], blv[tb][op], bc[tb], 0, 0, 0);
            bc[tb] = __builtin_amdgcn_mfma_f32_32x32x16_bf16(ltri[op], bhv[tb][op], bc[tb], 0, 0, 0);
        }
    }
#pragma unroll
    for (int op = 0; op < 2; ++op) {
        bc[1] = __builtin_amdgcn_mfma_f32_32x32x16_bf16(lone, blv[0][op], bc[1], 0, 0, 0);
        bc[1] = __builtin_amdgcn_mfma_f32_32x32x16_bf16(lone, bhv[0][op], bc[1], 0, 0, 0);
    }
#pragma unroll
    for (int j = 0; j < 4; ++j) { const int idx = lane + 64 * j, row = idx >> 2, part = idx & 3; *(LAS u32x4*)(lq + row * 40 + part * 8) = gq4[j]; *(LAS u32x4*)(lk + row * 40 + part * 8) = gk4[j]; }
    LDS_WAIT();
    const float t63 = __shfl(bc[1][15], 32 + l32);
#pragma unroll
    for (int tb = 0; tb < 2; ++tb)
#pragma unroll
        for (int g4 = 0; g4 < 4; ++g4) {
            float kh[4];
#pragma unroll
            for (int e = 0; e < 4; ++e) { const int r = 4 * g4 + e, t = 32 * tb + 8 * g4 + 4 * hi + e;
                const float bcv = bc[tb][r], ee = fexp(bcv), ei = fexp(-bcv);
                const float qv = bf2f(lq[t * 40 + l32]), kv = bf2f(lk[t * 40 + l32]);
                kh[e] = kv * ei;
                lq[t * 40 + l32] = f2bf(qv * 0.08838834764831845f * ee); lk[t * 40 + l32] = f2bf(kh[e]); }
            u32x2 w; w.x = pk2(kh[0], kh[1]); w.y = pk2(kh[2], kh[3]);
            *(u32x2*)(pt + 32 * tb + 8 * g4) = w;
        }
    if (hi == 0) ED[((size_t)bh * 64 + chunk) * 128 + c] = fexp(t63);
    LDS_WAIT();
#pragma unroll
    for (int j = 0; j < 4; ++j) { const int idx = lane + 64 * j, row = idx >> 2, part = idx & 3; const size_t o_ = tile + (size_t)row * 128 + cb * 32 + part * 8;
        *(u32x4*)(GQ + o_) = *(const LAS u32x4*)(lq + row * 40 + part * 8); *(u32x4*)(GK + o_) = *(const LAS u32x4*)(lk + row * 40 + part * 8); }
    LDS_WAIT();
}

__device__ __forceinline__ void gla_state_block(LAS unsigned char* lds, const bf16_t* __restrict__ KT, const bf16_t* __restrict__ GVT, const float* __restrict__ ED, float* __restrict__ SLOC, float* __restrict__ DSEG, int bh, int seg) {
    int tid_ = threadIdx.x; asm volatile("" : "+v"(tid_));
    const int tid = tid_, lane = tid & 63, w = __builtin_amdgcn_readfirstlane(tid >> 6), l32 = lane & 31, hi = lane >> 5, b = bh >> 2, h = bh & 3;
    f32x16 S[4];
#pragma unroll
    for (int kt = 0; kt < 4; ++kt)
#pragma unroll
        for (int r = 0; r < 16; ++r) S[kt][r] = 0.f;
    bf16x8 vnx[4]; u32x4 ktn[2]; float edn = 0.f, dprod = 1.f;
#define GLA_ALOADS(chx) do { const size_t ck_ = (size_t)bh * 64 + seg * 8 + (chx); \
        { const bf16_t* vp_ = GVT + (((size_t)b * 64 + seg * 8 + (chx)) * 1024 + h * 256 + 32 * w + l32) * 64 + 8 * hi; _Pragma("unroll") for (int st = 0; st < 4; ++st) vnx[st] = *(const bf16x8*)(vp_ + 16 * st); } \
        _Pragma("unroll") for (int i = 0; i < 2; ++i) ktn[i] = *(const u32x4*)(KT + ck_ * 8192 + (size_t)(tid + 512 * i) * 8); \
        if (tid < 128) edn = ED[ck_ * 128 + tid]; } while (0)
    GLA_ALOADS(0);
    for (int ch = 0; ch < 8; ++ch) {
        LAS bf16_t* KTT = (LAS bf16_t*)(lds + (ch & 1) * 18432); LAS float* EDEC = (LAS float*)(lds + 36864 + (ch & 1) * 512);
#pragma unroll
        for (int i = 0; i < 2; ++i) { const int id = tid + 512 * i; *(LAS u32x4*)(KTT + (id >> 3) * 72 + (id & 7) * 8) = ktn[i]; }
        if (tid < 128) { EDEC[tid] = edn; dprod *= edn; }
        bf16x8 vreg[4];
#pragma unroll
        for (int st = 0; st < 4; ++st) vreg[st] = vnx[st];
        if (ch < 7) GLA_ALOADS(ch + 1);
        __builtin_amdgcn_sched_barrier(0);
        LDS_BARRIER();
#pragma unroll
        for (int kt = 0; kt < 4; ++kt) {
#pragma unroll
            for (int st = 0; st < 4; ++st) { const bf16x8 av = *(const LAS bf16x8*)(KTT + (32 * kt + l32) * 72 + 16 * st + 8 * hi);
                S[kt] = __builtin_amdgcn_mfma_f32_32x32x16_bf16(av, vreg[st], S[kt], 0, 0, 0); }
#pragma unroll
            for (int gq = 0; gq < 4; ++gq) { const f32x4 d4 = *(const LAS f32x4*)(EDEC + 32 * kt + 8 * gq + 4 * hi);
#pragma unroll
                for (int e = 0; e < 4; ++e) S[kt][4 * gq + e] *= d4[e]; }
        }
    }
#undef GLA_ALOADS
    float* sl = SLOC + (((size_t)(bh * 7 + seg) * 8 + w) * 64) * 64 + lane;
#pragma unroll
    for (int kt = 0; kt < 4; ++kt)
#pragma unroll
        for (int r = 0; r < 16; ++r) sl[(size_t)(kt * 16 + r) * 64] = S[kt][r];
    if (tid < 128) DSEG[(bh * 8 + seg) * 128 + tid] = dprod;
    LDS_BARRIER();
}

constexpr int G_QT = 0, G_KH = 17408, G_KTT = 34816, G_SC = 53248, G_EDEC = 62464, G_OS = 62976, G_GN = 130560;
struct GlaPtrs { const bf16_t* GQ; const bf16_t* GK; const bf16_t* GO; const bf16_t* GVT; const bf16_t* KT; const float* ED; const float* gn; bf16_t* OGLA; const float* SLOC; const float* DSEG; };

__device__ __forceinline__ void gla_out_unit(LAS unsigned char* lds, const GlaPtrs& g, int bh, int seg) {
    int tid_ = threadIdx.x; asm volatile("" : "+v"(tid_));
    const int tid = tid_, lane = tid & 63, w = __builtin_amdgcn_readfirstlane(tid >> 6), l32 = lane & 31, hi = lane >> 5;
    const int b = bh >> 2, h = bh & 3;
    LAS bf16_t* QT = (LAS bf16_t*)(lds + G_QT); LAS bf16_t* KH = (LAS bf16_t*)(lds + G_KH); LAS bf16_t* KTT = (LAS bf16_t*)(lds + G_KTT); LAS bf16_t* SC = (LAS bf16_t*)(lds + G_SC);
    LAS float* EDEC = (LAS float*)(lds + G_EDEC); LAS float* OS = (LAS float*)(lds + G_OS);
    f32x16 S[4];
#pragma unroll
    for (int kt = 0; kt < 4; ++kt)
#pragma unroll
        for (int r = 0; r < 16; ++r) S[kt][r] = 0.f;
    if (seg > 0) {
        LAS float* DST = OS;
        for (int i = tid; i < seg * 128; i += 512) DST[i] = g.DSEG[(bh * 8) * 128 + i];
        LDS_BARRIER();
        for (int j = 0; j < seg; ++j) {
            const float* sl = g.SLOC + (((size_t)(bh * 7 + j) * 8 + w) * 64) * 64 + lane;
#pragma unroll
            for (int kt = 0; kt < 4; ++kt)
#pragma unroll
                for (int gq = 0; gq < 4; ++gq) { const f32x4 d4 = *(const LAS f32x4*)(DST + j * 128 + 32 * kt + 8 * gq + 4 * hi);
#pragma unroll
                    for (int e = 0; e < 4; ++e) S[kt][4 * gq + e] = S[kt][4 * gq + e] * d4[e] + sl[(size_t)(kt * 16 + 4 * gq + e) * 64]; }
        }
        LDS_BARRIER();
    }
    bf16x8 vreg[4]; u32x4 qn[2], kn[2], ktn[2]; float edn = 0.f;
    LAS float* GN = (LAS float*)(lds + G_GN);
    LAS bf16_t* OSB2 = (LAS bf16_t*)(lds + G_OS);
    if (tid < 256) GN[tid] = g.gn[tid];
    const bool j1first = ((w & 1) == 0);
#define GLA_LOADS(chx) do { const size_t ck_ = (size_t)bh * 64 + seg * 8 + (chx); \
        _Pragma("unroll") for (int i = 0; i < 2; ++i) { const size_t o_ = ck_ * 8192 + (size_t)(tid + 512 * i) * 8; \
            qn[i] = *(const u32x4*)(g.GQ + o_); kn[i] = *(const u32x4*)(g.GK + o_); ktn[i] = *(const u32x4*)(g.KT + o_); } \
        edn = g.ED[ck_ * 128 + (tid & 127)]; } while (0)
#define GLA_VLOAD(chx) do { const bf16_t* vp_ = g.GVT + (((size_t)b * 64 + seg * 8 + (chx)) * 1024 + h * 256 + 32 * w + l32) * 64 + 8 * hi; _Pragma("unroll") for (int st = 0; st < 4; ++st) vreg[st] = *(const bf16x8*)(vp_ + 16 * st); } while (0)
    GLA_LOADS(0); GLA_VLOAD(0);
    for (int ch = 0; ch <= 8; ++ch) {
        const bool has = ch < 8;
        const int cp = ch > 0 ? ch - 1 : 0;
        const size_t tokp = (size_t)b * SEQ + seg * 512 + cp * 64;
        if (has) {
#pragma unroll
            for (int i = 0; i < 2; ++i) { const int id = tid + 512 * i;
                *(LAS u32x4*)(QT + (id >> 4) * 136 + (id & 15) * 8) = qn[i]; *(LAS u32x4*)(KH + (id >> 4) * 136 + (id & 15) * 8) = kn[i]; *(LAS u32x4*)(KTT + (id >> 3) * 72 + (id & 7) * 8) = ktn[i]; }
            if (tid < 128) EDEC[tid] = edn;
            GLA_LOADS(ch < 7 ? ch + 1 : 7);
        }
        __builtin_amdgcn_sched_barrier(0);
        LDS_BARRIER();
        if (has) {
            const int l16 = lane & 15, q4 = lane >> 4, ti = w >> 1;
#pragma unroll
            for (int sjj = 0; sjj < 2; ++sjj) { const int sj = 2 * (w & 1) + sjj; f32x4 a4 = (f32x4){0.f, 0.f, 0.f, 0.f};
#pragma unroll
                for (int kk = 0; kk < 4; ++kk) { const bf16x8 av = *(const LAS bf16x8*)(KH + (16 * sj + l16) * 136 + 32 * kk + 8 * q4); const bf16x8 bv = *(const LAS bf16x8*)(QT + (16 * ti + l16) * 136 + 32 * kk + 8 * q4);
                    a4 = __builtin_amdgcn_mfma_f32_16x16x32_bf16(av, bv, a4, 0, 0, 0); }
                const int tt_ = 16 * ti + l16, ss_ = 16 * sj + 4 * q4;
                u32x2 wv; wv.x = pk2(ss_ <= tt_ ? a4[0] : 0.f, ss_ + 1 <= tt_ ? a4[1] : 0.f); wv.y = pk2(ss_ + 2 <= tt_ ? a4[2] : 0.f, ss_ + 3 <= tt_ ? a4[3] : 0.f);
                *(LAS u32x2*)(SC + tt_ * 72 + ss_) = wv; }
        }
        LDS_BARRIER();
        auto J1 = [&]() __attribute__((always_inline)) {
            {
                if (has) {
                    LAS bf16_t* ob = OSB2 + (ch & 1) * (64 * 264) + 32 * w + l32;
#pragma unroll 1
                    for (int tt = 0; tt < 2; ++tt) {
                        f32x16 o;
#pragma unroll
                        for (int r = 0; r < 16; ++r) o[r] = 0.f;
#pragma unroll
                        for (int kt = 0; kt < 4; ++kt)
#pragma unroll
                            for (int op = 0; op < 2; ++op) {
                                const bf16x8 bs = pack8(S[kt][8 * op], S[kt][8 * op + 1], S[kt][8 * op + 2], S[kt][8 * op + 3], S[kt][8 * op + 4], S[kt][8 * op + 5], S[kt][8 * op + 6], S[kt][8 * op + 7]);
                                const LAS bf16_t* ap = QT + (32 * tt + l32) * 136 + 32 * kt + 16 * op + 4 * hi;
                                const u32x2 a0 = *(const LAS u32x2*)ap, a1 = *(const LAS u32x2*)(ap + 8);
                                u32x4 aw; aw.x = a0.x; aw.y = a0.y; aw.z = a1.x; aw.w = a1.y;
                                o = __builtin_amdgcn_mfma_f32_32x32x16_bf16(__builtin_bit_cast(bf16x8, aw), bs, o, 0, 0, 0); }
#pragma unroll
                        for (int st = 0; st < 4; ++st) { const bf16x8 av = *(const LAS bf16x8*)(SC + (32 * tt + l32) * 72 + 16 * st + 8 * hi);
                            o = __builtin_amdgcn_mfma_f32_32x32x16_bf16(av, vreg[st], o, 0, 0, 0); }
#pragma unroll
                        for (int r = 0; r < 16; ++r) ob[(32 * tt + (r & 3) + 8 * (r >> 2) + 4 * hi) * 264] = f2bf_v(o[r]);
                    }
#pragma unroll
                    for (int kt = 0; kt < 4; ++kt) {
#pragma unroll
                        for (int st = 0; st < 4; ++st) { const bf16x8 av = *(const LAS bf16x8*)(KTT + (32 * kt + l32) * 72 + 16 * st + 8 * hi);
                            S[kt] = __builtin_amdgcn_mfma_f32_32x32x16_bf16(av, vreg[st], S[kt], 0, 0, 0); }
#pragma unroll
                        for (int gq = 0; gq < 4; ++gq) { const f32x4 d4 = *(const LAS f32x4*)(EDEC + 32 * kt + 8 * gq + 4 * hi);
#pragma unroll
                            for (int e = 0; e < 4; ++e) S[kt][4 * gq + e] *= d4[e]; }
                    }
                    GLA_VLOAD(ch < 7 ? ch + 1 : 7);
                }
            }
        };
        auto J2 = [&]() __attribute__((always_inline)) {
            {
                if (ch > 0) {
                    const int t = tid >> 3, part = tid & 7;
                    u32x4 gocur[4];
                    { const bf16_t* gop_ = g.GO + (tokp + t) * 1024 + h * 256 + 32 * part;
#pragma unroll
                      for (int i = 0; i < 4; ++i) gocur[i] = *(const u32x4*)(gop_ + 8 * i); }
                    const LAS u32x4* op4 = (const LAS u32x4*)(OSB2 + (cp & 1) * (64 * 264) + t * 264 + 32 * part);
                    float ss = 0.f;
#pragma unroll
                    for (int i = 0; i < 4; ++i) { const u32x4 x = op4[i];
                        ss += (bflo(x.x) * bflo(x.x) + bfhi(x.x) * bfhi(x.x)) + (bflo(x.y) * bflo(x.y) + bfhi(x.y) * bfhi(x.y)) + (bflo(x.z) * bflo(x.z) + bfhi(x.z) * bfhi(x.z)) + (bflo(x.w) * bflo(x.w) + bfhi(x.w) * bfhi(x.w)); }
                    ss += __shfl_xor(ss, 1); ss += __shfl_xor(ss, 2); ss += __shfl_xor(ss, 4);
                    const float rs = rsqrtf(ss * (1.f / 256.f) + EPS);
                    bf16_t* dst = g.OGLA + (tokp + t) * 1536 + 512 + h * 256 + 32 * part; const LAS float* gnp = GN + 32 * part;
#pragma unroll
                    for (int i = 0; i < 4; ++i) { const u32x4 gw = gocur[i]; const u32x4 x = op4[i];
                        const float v[8] = {bflo(x.x), bfhi(x.x), bflo(x.y), bfhi(x.y), bflo(x.z), bfhi(x.z), bflo(x.w), bfhi(x.w)};
                        const f32x4 n0 = *(const LAS f32x4*)(gnp + 8 * i), n1 = *(const LAS f32x4*)(gnp + 8 * i + 4);
                        float gv[8] = {bflo(gw.x), bfhi(gw.x), bflo(gw.y), bfhi(gw.y), bflo(gw.z), bfhi(gw.z), bflo(gw.w), bfhi(gw.w)}; float ov[8];
#pragma unroll
                        for (int e = 0; e < 4; ++e) { ov[e] = v[e] * rs * n0[e] * (gv[e] * sigmoidf(gv[e])); ov[4 + e] = v[4 + e] * rs * n1[e] * (gv[4 + e] * sigmoidf(gv[4 + e])); }
                        u32x4 wv; wv.x = pk2(ov[0], ov[1]); wv.y = pk2(ov[2], ov[3]); wv.z = pk2(ov[4], ov[5]); wv.w = pk2(ov[6], ov[7]);
                        *(u32x4*)(dst + 8 * i) = wv; }
                }
            }
        };
        if (j1first) { J1(); J2(); } else { J2(); J1(); }
        LDS_BARRIER();
    }
#undef GLA_LOADS
#undef GLA_VLOAD
    LDS_BARRIER();
}


#define XB_TMO      128
#define XB_XCNT(j)  (256  + 64 * (j))
#define XB_XSUB(j)  (1280 + 64 * (j))
#define XB_XGEN(j)  (2304 + 64 * (j))
#define XB_TOP      3328
#define XB_TOPGEN   3392
#define XCD_BAR_WORDS 3456
#define XB_SPIN_CAP (1u << 18)

__device__ __forceinline__ unsigned xb_ld(unsigned* p)              { return __hip_atomic_load(p, __ATOMIC_RELAXED, __HIP_MEMORY_SCOPE_AGENT); }
__device__ __forceinline__ unsigned xb_add(unsigned* p, unsigned v) { return __hip_atomic_fetch_add(p, v, __ATOMIC_RELAXED, __HIP_MEMORY_SCOPE_AGENT); }
__device__ __forceinline__ unsigned xb_xcc_id() { return (unsigned)__builtin_amdgcn_s_getreg((3 << 11) | 20) & 0xFu; }
#define XB_SPIN(cond, bar) do { unsigned _sp = 0; while (cond) { __builtin_amdgcn_s_sleep(1); \
    if ((++_sp & 255u) == 0u) { if (xb_ld(&(bar)[XB_TMO])) break; if (_sp > XB_SPIN_CAP) { atomicAdd(&(bar)[XB_TMO], 1u); break; } } } } while (0)

struct XcdBarrier {
    unsigned* bar; unsigned x;
    volatile LAS unsigned* st;
};

__device__ __forceinline__ XcdBarrier xcd_barrier_post(unsigned* bar, volatile LAS unsigned* st) {
    XcdBarrier b; b.bar = bar; b.x = xb_xcc_id(); b.st = st;
    if (threadIdx.x == 0) (void)xb_add(&bar[XB_XCNT(b.x)], 1u);
    return b;
}
__device__ __forceinline__ void xcd_barrier_complete(unsigned* bar, unsigned x, unsigned& nloc, unsigned& nx) {
    const unsigned G = gridDim.x * gridDim.y * gridDim.z;
    unsigned sum, cnt, mine, sp = 0u;
    for (;;) {
        sum = 0u; cnt = 0u; mine = 0u;
#pragma unroll
        for (unsigned j = 0; j < 16; ++j) { const unsigned c = xb_ld(&bar[XB_XCNT(j)]); sum += c; cnt += (c > 0u) ? 1u : 0u; mine = (j == x) ? c : mine; }
        if (sum == G) break;
        __builtin_amdgcn_s_sleep(1);
        if ((++sp & 255u) == 0u) { if (xb_ld(&bar[XB_TMO])) break; if (sp > XB_SPIN_CAP) { atomicAdd(&bar[XB_TMO], 1u); break; } }
    }
    nloc = mine > 0u ? mine : 1u; nx = cnt > 0u ? cnt : 1u;
}

__device__ __forceinline__ void xcd_barrier(const XcdBarrier& b) {
    asm volatile("s_waitcnt vmcnt(0)" ::: "memory");
    __syncthreads();
    if (threadIdx.x == 0) {
        unsigned* bar = b.bar;
        __builtin_amdgcn_s_waitcnt(0);
        unsigned nloc = b.st[0], nx = b.st[1];
        if (nloc == 0u) { xcd_barrier_complete(bar, b.x, nloc, nx); b.st[0] = nloc; b.st[1] = nx; }
        const unsigned old = xb_add(&bar[XB_XSUB(b.x)], 1u);
        const unsigned gen = old / nloc;
        if (old + 1u == (gen + 1u) * nloc) {
            __builtin_amdgcn_fence(__ATOMIC_RELEASE, "agent");
            asm volatile("s_waitcnt vmcnt(0)" ::: "memory");
            const unsigned og = xb_add(&bar[XB_TOP], 1u);
            const unsigned tg = og / nx;
            if (og + 1u == (tg + 1u) * nx) xb_add(&bar[XB_TOPGEN], 1u);
            else XB_SPIN(xb_ld(&bar[XB_TOPGEN]) == tg, bar);
            __builtin_amdgcn_fence(__ATOMIC_ACQUIRE, "agent");
            xb_add(&bar[XB_XGEN(b.x)], 1u);
            asm volatile("s_waitcnt vmcnt(0)" ::: "memory");
        } else {
            XB_SPIN(xb_ld(&bar[XB_XGEN(b.x)]) == gen, bar);
            __builtin_amdgcn_fence(__ATOMIC_ACQUIRE, "agent");
            asm volatile("s_waitcnt vmcnt(0)" ::: "memory");
        }
    }
    __syncthreads();
}

struct Args { const float* in[13]; float* out; unsigned char* ws; };
__global__ void __launch_bounds__(512, 2) fwd_kernel(Args a) {
    extern __shared__ __attribute__((aligned(16))) unsigned char lds_raw[];
    LAS unsigned char* lds = (LAS unsigned char*)lds_raw;
    cg::grid_group grid = cg::this_grid();
    volatile LAS unsigned* MISC = (volatile LAS unsigned*)(lds + MISC_OFF);
    if (threadIdx.x < 4) MISC[threadIdx.x] = 0u;
    __syncthreads();
    unsigned* barw = (unsigned*)(a.ws + WS_BAR);
#define PHASE_IDS() int tid_ = threadIdx.x; asm volatile("" : "+v"(tid_)); const int tid = tid_, lane = tid & 63, wave = __builtin_amdgcn_readfirstlane(tid >> 6), gw = bid * 8 + wave, NGW = G * 8; (void)tid; (void)lane; (void)gw; (void)NGW
    const int G = gridDim.x, bid = blockIdx.x;
    unsigned char* ws = a.ws; unsigned char* dout = (unsigned char*)a.out;
    const float* x = a.in[0];
    float* SS1 = (float*)(ws + WS_SS1); float* SS2 = (float*)(ws + WS_SS2); float* DSEG = (float*)(ws + WS_DSEG); float* ED = (float*)(ws + WS_ED); bf16_t* KT = (bf16_t*)(ws + WS_KT); float* GLOW = (float*)(ws + WS_GLOW);
    bf16_t* WinT = (bf16_t*)(ws + WS_WIN); bf16_t* WpcT = (bf16_t*)(ws + WS_WPA); bf16_t* WoutT = (bf16_t*)(ws + WS_WOUT);
    bf16_t* W1T = (bf16_t*)(ws + WS_W1); bf16_t* W2T = (bf16_t*)(ws + WS_W2);
    bf16_t* HB = (bf16_t*)(ws + WS_HB); bf16_t* OC = (bf16_t*)(ws + WS_OC); bf16_t* GO = (bf16_t*)(dout + DO_GO); bf16_t* GATES = (bf16_t*)(ws + WS_GATES); bf16_t* GQ = (bf16_t*)(ws + WS_GQ); bf16_t* GK = (bf16_t*)(ws + WS_GK);
    bf16_t* QH = (bf16_t*)(ws + WS_QH); bf16_t* KH = (bf16_t*)(ws + WS_KH); bf16_t* HID = (bf16_t*)(ws + WS_HID); float* SLOC = (float*)(ws + WS_SLOC);
    bf16_t* GVT = (bf16_t*)(dout + DO_GVT); bf16_t* VT = (bf16_t*)(ws + WS_VT); bf16_t* MIX = (bf16_t*)(dout + DO_GVT);

    {
        PHASE_IDS();
        for (int i = bid * 512 + tid; i < T; i += G * 512) { SS1[i] = 0.f; SS2[i] = 0.f; }
        if (bid == 0) for (int i = tid; i < XCD_BAR_WORDS; i += 512) __hip_atomic_store(barw + i, 0u, __ATOMIC_RELAXED, __HIP_MEMORY_SCOPE_AGENT);
        LAS float* scr = (LAS float*)(lds + wave * 16384);
        constexpr int I_IN = 16 * (NWIN / 32);
        for (int r = gw; r < I_IN; r += NGW) { const int nb = r % (NWIN / 32), kb = r / (NWIN / 32); transpose_item(a.in[2], D, DIN, WinT, 32 * nb, 64 * kb, 64 * kb, win_src(32 * nb + (lane & 31)), nullptr, scr, lane); }
        const float* gmix = a.in[1];
        for (int m0 = gw * 8; m0 < T; m0 += NGW * 8) {
            f32x4 v[8][4]; float sq[8];
#pragma unroll
            for (int rr = 0; rr < 8; ++rr) { const f32x4* xr = (const f32x4*)(x + (size_t)(m0 + rr) * D) + lane;
#pragma unroll
                for (int j = 0; j < 4; ++j) v[rr][j] = xr[64 * j]; }
#pragma unroll
            for (int rr = 0; rr < 8; ++rr) { float s = 0.f;
#pragma unroll
                for (int j = 0; j < 4; ++j) s += (v[rr][j][0] * v[rr][j][0] + v[rr][j][1] * v[rr][j][1]) + (v[rr][j][2] * v[rr][j][2] + v[rr][j][3] * v[rr][j][3]);
                sq[rr] = rsqrtf(wave_sum(s) * (1.f / D) + EPS); }
#pragma unroll
            for (int j = 0; j < 4; ++j) { const f32x4 gg = ((const f32x4*)gmix)[lane + 64 * j];
#pragma unroll
                for (int rr = 0; rr < 8; ++rr) { u32x2 w; w.x = pk2(v[rr][j][0] * sq[rr] * gg[0], v[rr][j][1] * sq[rr] * gg[1]); w.y = pk2(v[rr][j][2] * sq[rr] * gg[2], v[rr][j][3] * sq[rr] * gg[3]);
                    ((u32x2*)(HB + (size_t)(m0 + rr) * D))[lane + 64 * j] = w; } }
        }
    }
    grid.sync();
    const XcdBarrier xbar = xcd_barrier_post(barw, MISC);

    {
        pg8::Gemm g{HB, WinT, T, NWIN, D}; pg8::StaticOrder S; S.init(T, NWIN, G, bid);
        Epi<E_INPROJ> E{}; E.QH = QH; E.KH = KH; E.GQ = GQ; E.GK = GK; E.GO = GO; E.GATES = GATES; E.VT = VT; E.GVT = GVT; E.GLOW = GLOW;
        pg8::gemm_phase<Epi<E_INPROJ>, pg8::StaticOrder, true, true>(lds, g, S, E);
        const int tb0 = G > 128 ? 128 : 0, tnb = G - tb0;
        if (bid >= tb0) {
            PHASE_IDS();
            LAS float* scr = (LAS float*)(lds + wave * 16384);
            constexpr int I_PA = 8 * 32, I_PB = 16 * 32, I_WO = 16 * 32, I_1 = 16 * 128, I_2 = 64 * 32, NIT = I_PA + I_PB + I_WO + I_1 + I_2;
            for (int it = (bid - tb0) * 8 + wave; it < NIT; it += tnb * 8) {
                int r = it;
                if (r < I_PA) { const int nb = r % 32, kb = r / 32; transpose_item(a.in[6], 1536, D, WpcT, 32 * nb, 64 * kb, 64 * kb, 32 * nb + (lane & 31), nullptr, scr, lane); continue; } r -= I_PA;
                if (r < I_PB) { const int nb = r % 32, kb = r / 32; transpose_item(a.in[7], 1536, D, WpcT, 32 * nb, 64 * kb, 512 + 64 * kb, 32 * nb + (lane & 31), nullptr, scr, lane); continue; } r -= I_PB;
                if (r < I_WO) { const int nb = r % 32, kb = r / 32; transpose_item(a.in[8], D, D, WoutT, 32 * nb, 64 * kb, 64 * kb, 32 * nb + (lane & 31), nullptr, scr, lane); continue; } r -= I_WO;
                if (r < I_1) { const int nb = r % 128, kb = r / 128; transpose_item(a.in[10], D, FF, W1T, 32 * nb, 64 * kb, 64 * kb, 32 * nb + (lane & 31), a.in[9], scr, lane); continue; } r -= I_1;
                { const int nb = r % 32, kb = r / 32; transpose_item(a.in[11], FF, D, W2T, 32 * nb, 64 * kb, 64 * kb, 32 * nb + (lane & 31), nullptr, scr, lane); }
            }
        }
    }
    xcd_barrier(xbar);

    {
        PHASE_IDS();
        for (int u = gw; u < 32 * 64 * 4; u += NGW) gla_prep_unit((LAS bf16_t*)(lds + wave * 10240), GQ, GK, GLOW, a.in[3], a.in[4], KT, ED, u >> 8, (u >> 2) & 63, u & 3, lane);
    }
    xcd_barrier(xbar);

    {
        PHASE_IDS();
        for (int u = bid; u < 32 * 7; u += G) gla_state_block(lds, KT, GVT, ED, SLOC, DSEG, u / 7, u % 7);
        for (int u = gw; u < NB * 8 * 128; u += NGW) sb_attn_unit(QH, KH, VT, OC, u >> 10, (u >> 7) & 7, u & 127, lane);
    }
    xcd_barrier(xbar);

    {
        GlaPtrs gp{GQ, GK, GO, GVT, KT, ED, a.in[5], OC, SLOC, DSEG};
        for (int u = bid; u < 256; u += G) gla_out_unit(lds, gp, u >> 3, u & 7);
    }
    xcd_barrier(xbar);

    {
        pg8::Gemm g{OC, WpcT, T, D, 1536}; pg8::StaticOrder S; S.init(T, D, G, bid);
        Epi<E_PMIX> E{}; E.GATES = GATES; E.MIX = MIX;
        pg8::gemm_phase<Epi<E_PMIX>, pg8::StaticOrder, true, true>(lds, g, S, E);
    }
    xcd_barrier(xbar);

    {
        pg8::Gemm g{MIX, WoutT, T, D, D}; pg8::StaticOrder S; S.init(T, D, G, bid);
        Epi<E_WOUT> E{}; E.XIN = x; E.XB = HB; E.SS = SS1;
        pg8::gemm_phase<Epi<E_WOUT>, pg8::StaticOrder, true, true>(lds, g, S, E);
    }
    xcd_barrier(xbar);

    {
        pg8::Gemm g{HB, W1T, T, FF, D}; pg8::StaticOrder S; S.init(T, FF, G, bid);
        Epi<E_FF1> E{}; E.SS = SS1; E.HID = HID;
        pg8::gemm_phase<Epi<E_FF1>, pg8::StaticOrder, true, true>(lds, g, S, E);
    }
    xcd_barrier(xbar);

    {
        pg8::Gemm g{HID, W2T, T, D, FF}; RevOrder S; S.init(T, D, G, bid);
        Epi<E_FF2> E{}; E.XBIN = HB; E.XB = (bf16_t*)(ws + WS_X2B); E.SS = SS2;
        pg8::gemm_phase<Epi<E_FF2>, RevOrder, true, true>(lds, g, S, E);
    }
    xcd_barrier(xbar);

    {
        PHASE_IDS();
        const float* gf = a.in[12];
        const bf16_t* X2B = (const bf16_t*)(ws + WS_X2B);
        for (int m0 = gw * 4; m0 < T; m0 += NGW * 4) {
            u32x2 v[4][4]; float rs[4];
#pragma unroll
            for (int rr = 0; rr < 4; ++rr) { const u32x2* xr = (const u32x2*)(X2B + (size_t)(m0 + rr) * D) + lane; rs[rr] = rsqrtf(SS2[m0 + rr] * (1.f / D) + EPS);
#pragma unroll
                for (int j = 0; j < 4; ++j) v[rr][j] = xr[64 * j]; }
#pragma unroll
            for (int j = 0; j < 4; ++j) { const f32x4 gg = ((const f32x4*)gf)[lane + 64 * j];
#pragma unroll
                for (int rr = 0; rr < 4; ++rr) { const f32x4 xv = (f32x4){bflo(v[rr][j].x), bfhi(v[rr][j].x), bflo(v[rr][j].y), bfhi(v[rr][j].y)};
                    ((f32x4*)(a.out + (size_t)(m0 + rr) * D))[lane + 64 * j] = xv * rs[rr] * gg; } }
        }
    }
}

extern "C" void kernel_launch(void* const* d_in, const int* in_sizes, int n_in, void* d_out, int out_size, void* d_ws, size_t ws_size, hipStream_t stream) {
    static int grid = 0;
    if (grid == 0) {
        if (n_in != 13 || in_sizes[0] != T * D || out_size != T * D || ws_size < WS_END) { fprintf(stderr, "kernel_launch: unexpected shapes (n_in %d, in0 %d, out %d, ws %zu)\n", n_in, n_in > 0 ? in_sizes[0] : -1, out_size, ws_size); grid = -1; return; }
        int dev = 0, cus = 0, per_cu = 0;
        hipGetDevice(&dev); hipDeviceGetAttribute(&cus, hipDeviceAttributeMultiprocessorCount, dev);
        if (hipFuncSetAttribute((const void*)fwd_kernel, hipFuncAttributeMaxDynamicSharedMemorySize, LDS_BYTES) != hipSuccess) { fprintf(stderr, "kernel_launch: hipFuncSetAttribute failed\n"); grid = -1; return; }
        if (hipOccupancyMaxActiveBlocksPerMultiprocessor(&per_cu, (const void*)fwd_kernel, 512, LDS_BYTES) != hipSuccess || per_cu < 1) { fprintf(stderr, "kernel_launch: occupancy query gave %d\n", per_cu); per_cu = 1; }
        (void)hipGetLastError();
        grid = cus * 1;
        fprintf(stderr, "kernel_launch: grid %d (cus %d, per_cu %d)\n", grid, cus, per_cu);
    }
    if (grid < 0) return;
    Args a{};
    for (int i = 0; i < 13; ++i) a.in[i] = (const float*)d_in[i];
    a.out = (float*)d_out; a.ws = (unsigned char*)d_ws;
    void* args[] = {&a};
    hipError_t e = hipLaunchCooperativeKernel((const void*)fwd_kernel, dim3(grid), dim3(512), args, LDS_BYTES, stream);
    if (e != hipSuccess) fprintf(stderr, "cooperative launch failed: %s (grid %d)\n", hipGetErrorString(e), grid);
}
```

```cpp
#include <hip/hip_runtime.h>
#include <hip/hip_cooperative_groups.h>
#include <cstdio>
#include <cstdint>
namespace cg = cooperative_groups;
namespace pg8 {
#define PG8_LAS __attribute__((address_space(3)))
typedef unsigned short bf16_t;
typedef short bf16x8 __attribute__((ext_vector_type(8)));
typedef float f32x4 __attribute__((ext_vector_type(4)));
typedef unsigned u32x4 __attribute__((ext_vector_type(4)));
constexpr int BM = 256, BK = 64, HALF = 128, HTB = HALF * BK * 2  , STAGE_BYTES = 8 * HTB, NXCD = 8, WGM = 8;

__host__ __device__ __forceinline__ int lds_byte(int r, int c) { const int st = (r >> 4) * 2 + (c >> 5), rr = r & 15, cc = c & 31, ob = rr * 64 + cc * 2; return st * 1024 + (ob ^ (((ob >> 9) & 1) << 5)); }
__host__ __device__ __forceinline__ void stage_rc(int b, int& R, int& C) { const int st = b / 1024, sb = b % 1024, swz = sb ^ (((sb >> 9) & 1) << 5); R = (st >> 1) * 16 + swz / 64; C = (st & 1) * 32 + (swz % 64) / 2; }
__host__ __device__ __forceinline__ int perm32(int rho) { const int n = rho >> 4, i = rho & 15; return 8 * (i >> 2) + 4 * n + (i & 3); }

struct Unit { int pm, pn; };
struct Gemm { const bf16_t* A; const bf16_t* Bt; int M, N, K; };

struct StaticOrder {
    int nM, nN, nwg, G, c;
    __host__ __device__ void init(int M, int N, int G_, int c_) { nM = M / BM; nN = N / BM; nwg = nM * nN; G = G_; c = c_; }
    __host__ __device__ bool next(int i, Unit& u) const {
        const long L = (long)i * G + c; if (L >= nwg) return false;
        int wgid = (int)L; { const int q = nwg / NXCD, r = nwg % NXCD, xcd = wgid % NXCD, off = wgid / NXCD; wgid = (xcd < r ? xcd * (q + 1) : r * (q + 1) + (xcd - r) * q) + off; }
        const int nig = WGM * nN, gid = wgid / nig, fm = gid * WGM, gsz = (nM - fm) < WGM ? (nM - fm) : WGM;
        u.pm = fm + ((wgid % nig) % gsz); u.pn = (wgid % nig) / gsz; return true;
    }
    __device__ __forceinline__ void a_ready(const Unit&) const {}
    __device__ __forceinline__ void done(const Unit&) const {}
};

__device__ __forceinline__ unsigned cvt_pk_bf16(float lo, float hi) { unsigned r; asm volatile("v_cvt_pk_bf16_f32 %0, %1, %2" : "=v"(r) : "v"(lo), "v"(hi)); return r; }
template <class Epi, class Sched, bool ALIGN_EPI = false, bool SP2 = false>
__device__ __forceinline__ void gemm_phase(PG8_LAS unsigned char* lds, const Gemm g, const Sched& S, const Epi& E) {
    int tid_ = threadIdx.x; asm volatile("" : "+v"(tid_));
    const int tid = tid_, wid = __builtin_amdgcn_readfirstlane(tid >> 6), lane = tid & 63, wr = wid >> 2, wc = wid & 3, fr = lane & 15, fq = lane >> 4;
    const int K = g.K, nt = K / BK;
    unsigned voffA[2], voffB[2];
#pragma unroll
    for (int i = 0; i < 2; ++i) { int R, C; stage_rc(tid * 16 + i * 8192, R, C); const int Rb = Epi::PERM ? ((R & ~31) + perm32(R & 31)) : R;
        voffA[i] = (unsigned)(R * K + C) * 2u; voffB[i] = (unsigned)(Rb * K + C) * 2u; }
    const size_t kstep = (size_t)(BK * 2);
    const size_t hstep = (size_t)HALF * K * 2;
    const size_t tstep = 2 * hstep;
    const unsigned ldsw = (unsigned)wid * 1024u;
    const int aoff = lds_byte(wr * 64 + fr, fq * 8), boff = lds_byte(wc * 32 + fr, fq * 8);
#define PG8_SA(b, h) (((b) * 2 + (h)) * HTB)
#define PG8_SB(b, h) ((4 + (b) * 2 + (h)) * HTB)
#define PG8_STAGE(bufoff, gbase, voff) do { _Pragma("unroll") for (int _i = 0; _i < 2; ++_i) \
        __builtin_amdgcn_global_load_lds((const unsigned*)((const char*)(gbase) + (voff)[_i]), (PG8_LAS unsigned*)(lds + (bufoff) + ldsw + _i * 8192), 16, 0, 0); } while (0)
#define PG8_LDA(dst, b, h) do { _Pragma("unroll") for (int m = 0; m < 4; ++m) _Pragma("unroll") for (int k = 0; k < 2; ++k) dst[m][k] = *(const PG8_LAS bf16x8*)(lds + PG8_SA(b, h) + aoff + m * 2048 + k * 1024); } while (0)
#define PG8_LDB(dst, b, h) do { _Pragma("unroll") for (int n = 0; n < 2; ++n) _Pragma("unroll") for (int k = 0; k < 2; ++k) dst[n][k] = *(const PG8_LAS bf16x8*)(lds + PG8_SB(b, h) + boff + n * 2048 + k * 1024); } while (0)
#define PG8_MMA(ai, bj, At, Bt) do { __builtin_amdgcn_s_setprio(1); _Pragma("unroll") for (int m = 0; m < 4; ++m) _Pragma("unroll") for (int n = 0; n < 2; ++n) _Pragma("unroll") for (int k = 0; k < 2; ++k) \
        acc[ai][bj][m][n] = __builtin_amdgcn_mfma_f32_16x16x32_bf16(Bt[n][k], At[m][k], acc[ai][bj][m][n], 0, 0, 0); __builtin_amdgcn_s_setprio(0); } while (0)
#define PG8_WAIT_V(n) asm volatile("s_waitcnt vmcnt(" #n ")" ::: "memory")
#define PG8_WAIT_L(n) asm volatile("s_waitcnt lgkmcnt(" #n ")" ::: "memory")
#define PG8_BAR __builtin_amdgcn_s_barrier()
#define PG8_SCHED __builtin_amdgcn_sched_barrier(0)
    Unit cur, nxt; int ui = 0;
    if (!S.next(0, cur)) return;
    f32x4 acc[2][2][4][2];
#pragma unroll
    for (int a = 0; a < 2; ++a)
#pragma unroll
        for (int b = 0; b < 2; ++b)
#pragma unroll
            for (int m = 0; m < 4; ++m)
#pragma unroll
                for (int n = 0; n < 2; ++n) acc[a][b][m][n] = (f32x4){0.f, 0.f, 0.f, 0.f};
    bf16x8 At[4][2], B0[2][2], B1[2][2];
    const char* cA = (const char*)g.A + (size_t)cur.pm * tstep; const char* cB = (const char*)g.Bt + (size_t)cur.pn * tstep;
    S.a_ready(cur);
    if constexpr (SP2) {
        PG8_STAGE(PG8_SB(0, 0), cB, voffB); PG8_STAGE(PG8_SB(0, 1), cB + hstep, voffB); PG8_STAGE(PG8_SA(0, 0), cA, voffA); PG8_STAGE(PG8_SA(0, 1), cA + hstep, voffA);
        if (wr == 1) PG8_BAR;
        PG8_WAIT_V(2); PG8_BAR;
        PG8_STAGE(PG8_SB(1, 0), cB + kstep, voffB); PG8_STAGE(PG8_SA(1, 0), cA + kstep, voffA); PG8_STAGE(PG8_SB(1, 1), cB + hstep + kstep, voffB);
        PG8_WAIT_V(6); PG8_BAR;
    } else {
        PG8_STAGE(PG8_SB(0, 0), cB, voffB); PG8_STAGE(PG8_SA(0, 0), cA, voffA); PG8_STAGE(PG8_SB(0, 1), cB + hstep, voffB); PG8_STAGE(PG8_SA(0, 1), cA + hstep, voffA);
        if (wr == 1) PG8_BAR;
        PG8_WAIT_V(4); PG8_BAR;
        PG8_STAGE(PG8_SB(1, 0), cB + kstep, voffB); PG8_STAGE(PG8_SA(1, 0), cA + kstep, voffA); PG8_STAGE(PG8_SB(1, 1), cB + hstep + kstep, voffB);
        PG8_WAIT_V(6); PG8_BAR;
    }
    for (;;) {
        const bool has_next = S.next(ui + 1, nxt);
        const char* nA = has_next ? (const char*)g.A + (size_t)nxt.pm * tstep : cA; const char* nB = has_next ? (const char*)g.Bt + (size_t)nxt.pn * tstep : cB;
        for (int t = 0; t < nt; t += 2) {
            if constexpr (Epi::MIDK > 0) { if (t == Epi::MIDK) E.mid(acc, cur, wr, wc, fr, fq); }
            const bool last = (t == nt - 2);
            const char* a1 = cA + (size_t)(t + 1) * kstep;
            const char* a2 = last ? nA : cA + (size_t)(t + 2) * kstep; const char* b2 = last ? nB : cB + (size_t)(t + 2) * kstep;
            const char* a3 = a2 + kstep; const char* b3 = b2 + kstep;
            if (last && has_next) S.a_ready(nxt);
            if constexpr (SP2) {
            PG8_LDB(B0, 0, 0); PG8_LDB(B1, 0, 1); PG8_SCHED; PG8_LDA(At, 0, 0); PG8_STAGE(PG8_SA(1, 1), a1 + hstep, voffA);
            PG8_WAIT_V(8); PG8_WAIT_L(0); PG8_BAR; PG8_MMA(0, 0, At, B0); PG8_MMA(0, 1, At, B1); PG8_BAR; PG8_SCHED;
            PG8_LDA(At, 0, 1); PG8_STAGE(PG8_SB(0, 0), b2, voffB); PG8_STAGE(PG8_SB(0, 1), b2 + hstep, voffB); PG8_STAGE(PG8_SA(0, 0), a2, voffA);
            PG8_WAIT_V(8); PG8_WAIT_L(0); PG8_BAR; PG8_MMA(1, 0, At, B0); PG8_MMA(1, 1, At, B1); PG8_BAR; PG8_SCHED;
            PG8_LDB(B0, 1, 0); PG8_LDB(B1, 1, 1); PG8_SCHED; PG8_LDA(At, 1, 0); PG8_STAGE(PG8_SA(0, 1), a2 + hstep, voffA);
            PG8_WAIT_V(8); PG8_WAIT_L(0); PG8_BAR; PG8_MMA(0, 0, At, B0); PG8_MMA(0, 1, At, B1); PG8_BAR; PG8_SCHED;
            PG8_LDA(At, 1, 1); PG8_STAGE(PG8_SB(1, 0), b3, voffB); PG8_STAGE(PG8_SB(1, 1), b3 + hstep, voffB); PG8_STAGE(PG8_SA(1, 0), a3, voffA);
            PG8_WAIT_V(8); PG8_WAIT_L(0); PG8_BAR; PG8_MMA(1, 0, At, B0); PG8_MMA(1, 1, At, B1); PG8_BAR; PG8_SCHED;
            } else {
            PG8_LDB(B0, 0, 0); PG8_SCHED; PG8_LDA(At, 0, 0); PG8_STAGE(PG8_SA(1, 1), a1 + hstep, voffA);
            PG8_WAIT_L(8); PG8_BAR; PG8_WAIT_L(0); PG8_MMA(0, 0, At, B0); PG8_BAR; PG8_SCHED;
            PG8_LDB(B1, 0, 1); PG8_STAGE(PG8_SB(0, 0), b2, voffB);
            PG8_BAR; PG8_WAIT_L(0); PG8_MMA(0, 1, At, B1); PG8_BAR;
            PG8_LDA(At, 0, 1); PG8_STAGE(PG8_SA(0, 0), a2, voffA);
            PG8_BAR; PG8_WAIT_L(0); PG8_MMA(1, 0, At, B0); PG8_BAR; PG8_SCHED;
            PG8_STAGE(PG8_SB(0, 1), b2 + hstep, voffB);
            PG8_WAIT_V(6); PG8_BAR; PG8_MMA(1, 1, At, B1); PG8_BAR;
            PG8_LDB(B0, 1, 0); PG8_SCHED; PG8_LDA(At, 1, 0); PG8_STAGE(PG8_SA(0, 1), a2 + hstep, voffA);
            PG8_WAIT_L(8); PG8_BAR; PG8_WAIT_L(0); PG8_MMA(0, 0, At, B0); PG8_BAR; PG8_SCHED;
            PG8_LDB(B1, 1, 1); PG8_STAGE(PG8_SB(1, 0), b3, voffB);
            PG8_BAR; PG8_WAIT_L(0); PG8_MMA(0, 1, At, B1); PG8_BAR;
            PG8_LDA(At, 1, 1); PG8_STAGE(PG8_SA(1, 0), a3, voffA);
            PG8_BAR; PG8_WAIT_L(0); PG8_MMA(1, 0, At, B0); PG8_BAR; PG8_SCHED;
            PG8_STAGE(PG8_SB(1, 1), b3 + hstep, voffB);
            PG8_WAIT_V(6); PG8_BAR; PG8_MMA(1, 1, At, B1); PG8_BAR;
            }
        }
        if constexpr (ALIGN_EPI) { if (wr == 0) PG8_BAR; }
        if constexpr (!Epi::AFTER_DRAIN) { E(acc, cur, wr, wc, fr, fq); S.done(cur); }
        if (!has_next) break;
#pragma unroll
        for (int a = 0; a < 2; ++a)
#pragma unroll
            for (int b = 0; b < 2; ++b)
#pragma unroll
                for (int m = 0; m < 4; ++m)
#pragma unroll
                    for (int n = 0; n < 2; ++n) acc[a][b][m][n] = (f32x4){0.f, 0.f, 0.f, 0.f};
        cur = nxt; cA = nA; cB = nB; ++ui;
        if constexpr (ALIGN_EPI) { if (wr == 1) PG8_BAR; }
    }
    PG8_WAIT_V(0);
    if constexpr (!ALIGN_EPI) { if (wr == 0) PG8_BAR; }
    PG8_BAR;
    if constexpr (Epi::AFTER_DRAIN) { E.fused(acc, cur, wr, wc, fr, fq, lds, wid, lane); S.done(cur); }
#undef PG8_SA
#undef PG8_SB
#undef PG8_STAGE
#undef PG8_LDA
#undef PG8_LDB
#undef PG8_MMA
#undef PG8_WAIT_V
#undef PG8_WAIT_L
#undef PG8_BAR
#undef PG8_SCHED
}
}

#define LAS __attribute__((address_space(3)))
typedef unsigned short bf16_t;
typedef short bf16x8 __attribute__((ext_vector_type(8)));
typedef float f32x4 __attribute__((ext_vector_type(4)));
typedef float f32x16 __attribute__((ext_vector_type(16)));
typedef unsigned u32x4 __attribute__((ext_vector_type(4)));
typedef unsigned u32x2 __attribute__((ext_vector_type(2)));

constexpr int NB = 8, SEQ = 4096, T = NB * SEQ, D = 1024, FF = 4096, DIN = 6672;
constexpr int NWIN = 6912;
constexpr float EPS = 1e-6f;
constexpr size_t MiB = 1u << 20;
constexpr size_t WS_SS1 = 0, WS_SS2 = 128 * 1024, WS_DSEG = 256 * 1024, WS_ED = 3 * MiB, WS_KT = 420 * MiB;
constexpr size_t WS_GLOW = 1 * MiB, WS_WIN = 4 * MiB, WS_WPA = 18 * MiB, WS_WPB = 19 * MiB, WS_WOUT = 21 * MiB, WS_W1 = 23 * MiB, WS_W2 = 31 * MiB;
constexpr size_t WS_X2B = 104 * MiB;
constexpr size_t WS_HB = 40 * MiB, WS_OC = 40 * MiB, WS_GATES = 136 * MiB, WS_GQ = 264 * MiB, WS_GK = 296 * MiB, WS_QH = 328 * MiB, WS_KH = 360 * MiB, WS_SLOC = 392 * MiB, WS_VT = 452 * MiB, WS_HID = 232 * MiB, WS_END = 488 * MiB;
constexpr size_t DO_GVT = 0, DO_GO = 64 * MiB;
constexpr int LDS_BYTES = 147456, MISC_OFF = LDS_BYTES - 64;
constexpr size_t WS_BAR = 512 * 1024;

__device__ __forceinline__ float bf2f(unsigned short v) { return __uint_as_float((unsigned)v << 16); }
__device__ __forceinline__ float bflo(unsigned v) { return __uint_as_float(v << 16); }
__device__ __forceinline__ float bfhi(unsigned v) { return __uint_as_float(v & 0xffff0000u); }
__device__ __forceinline__ unsigned pk2(float lo, float hi) { return pg8::cvt_pk_bf16(lo, hi); }
__device__ __forceinline__ unsigned short f2bf(float f) { return (unsigned short)(pg8::cvt_pk_bf16(f, 0.f) & 0xffffu); }
typedef float f32x2_t __attribute__((ext_vector_type(2))); typedef __bf16 bf16x2_t __attribute__((ext_vector_type(2)));
__device__ __forceinline__ unsigned pk2_v(float lo, float hi) { f32x2_t v = {lo, hi}; bf16x2_t b = __builtin_convertvector(v, bf16x2_t); return __builtin_bit_cast(unsigned, b); }
__device__ __forceinline__ unsigned short f2bf_v(float f) { f32x2_t v = {f, 0.f}; bf16x2_t b = __builtin_convertvector(v, bf16x2_t); return (unsigned short)(__builtin_bit_cast(unsigned, b) & 0xffffu); }
__device__ __forceinline__ float fexp(float x) { return __expf(x); }
__device__ __forceinline__ float softplus(float z) { return fmaxf(z, 0.f) + __logf(1.f + __expf(-fabsf(z))); }
__device__ __forceinline__ float sigmoidf(float x) { return __builtin_amdgcn_rcpf(1.f + __expf(-x)); }
__device__ __forceinline__ float wave_sum(float v) {
#pragma unroll
    for (int o = 1; o < 64; o <<= 1) v += __shfl_xor(v, o);
    return v;
}
__device__ __forceinline__ bf16x8 pack8(float a0, float a1, float a2, float a3, float a4, float a5, float a6, float a7) {
    u32x4 w; w.x = pk2(a0, a1); w.y = pk2(a2, a3); w.z = pk2(a4, a5); w.w = pk2(a6, a7); return __builtin_bit_cast(bf16x8, w);
}
#define LDS_WAIT() asm volatile("s_waitcnt lgkmcnt(0)" ::: "memory")
#define LDS_BARRIER() do { asm volatile("s_waitcnt lgkmcnt(0)" ::: "memory"); __builtin_amdgcn_s_barrier(); asm volatile("" ::: "memory"); } while (0)

enum { E_INPROJ = 0, E_PMIX = 1, E_WOUT = 3, E_FF1 = 4, E_FF2 = 5 };
template <int MODE> struct Epi {
    static constexpr bool PERM = (MODE == E_INPROJ || MODE == E_PMIX || MODE == E_FF1), AFTER_DRAIN = false;
    static constexpr int MIDK = (MODE == E_PMIX) ? 8 : 0;
    bf16_t* QH; bf16_t* KH; bf16_t* GQ; bf16_t* GK; bf16_t* GO; bf16_t* GATES; bf16_t* VT; bf16_t* GVT; float* GLOW;
    bf16_t* MIX;
    const float* XIN; const bf16_t* XBIN; bf16_t* XB; float* SS;
    bf16_t* HID;
    static __device__ __forceinline__ float sigB(float g) { return __builtin_amdgcn_rcpf(1.f + fminf(__expf(-g), 1e20f)); }
    static __device__ __forceinline__ float ratioAB(float ga, float gb) { return (1.f + fminf(__expf(-gb), 1e20f)) * __builtin_amdgcn_rcpf(1.f + __expf(-ga)); }
    __device__ __forceinline__ void mid(f32x4 (&acc)[2][2][4][2], const pg8::Unit& u, int wr, int wc, int fr, int fq) const {
        if constexpr (MODE == E_PMIX) {
            int fr_ = fr, fq_ = fq; asm volatile("" : "+v"(fr_), "+v"(fq_));
            const int row0 = u.pm * 256 + wr * 64 + fr_, col0 = u.pn * 256 + wc * 32 + 8 * fq_;
#pragma unroll
            for (int ai = 0; ai < 2; ++ai)
#pragma unroll
                for (int m = 0; m < 4; ++m) { const size_t r = (size_t)(row0 + ai * 128 + m * 16);
#pragma unroll
                    for (int bj = 0; bj < 2; ++bj) {
                        const u32x4 ga = *(const u32x4*)(GATES + r * 2048 + col0 + bj * 128), gb = *(const u32x4*)(GATES + r * 2048 + 1024 + col0 + bj * 128);
                        f32x4 r0, r1;
                        r0[0] = ratioAB(bflo(ga.x), bflo(gb.x)); r0[1] = ratioAB(bfhi(ga.x), bfhi(gb.x)); r0[2] = ratioAB(bflo(ga.y), bflo(gb.y)); r0[3] = ratioAB(bfhi(ga.y), bfhi(gb.y));
                        r1[0] = ratioAB(bflo(ga.z), bflo(gb.z)); r1[1] = ratioAB(bfhi(ga.z), bfhi(gb.z)); r1[2] = ratioAB(bflo(ga.w), bflo(gb.w)); r1[3] = ratioAB(bfhi(ga.w), bfhi(gb.w));
                        acc[ai][bj][m][0] *= r0; acc[ai][bj][m][1] *= r1; }
                    if (m & 1) asm volatile("" ::: "memory"); }
        }
    }
    __device__ __forceinline__ void operator()(const f32x4 (&acc)[2][2][4][2], const pg8::Unit& u, int wr, int wc, int fr, int fq) const {
        const int row0 = u.pm * 256 + wr * 64 + fr;
        if constexpr (MODE == E_INPROJ) {
            if (u.pn < 20) {
                const int b = u.pm >> 4, s0 = (u.pm & 15) * 256 + wr * 64 + fr;
                bf16_t* base; size_t off0, rstride, bjstride;
                if (u.pn < 4) { base = (u.pn < 2) ? QH : KH;
                    off0 = ((size_t)(b * 8 + (u.pn & 1) * 4 + (wc >> 1)) * SEQ + s0) * 64 + (wc & 1) * 32 + 8 * fq; rstride = 64; bjstride = (size_t)2 * SEQ * 64; }
                else if (u.pn < 8) { base = (u.pn < 6) ? GQ : GK;
                    off0 = ((size_t)(b * 4 + (u.pn & 1) * 2) * SEQ + s0) * 128 + wc * 32 + 8 * fq; rstride = 128; bjstride = (size_t)SEQ * 128; }
                else if (u.pn < 12) { base = GO; off0 = (size_t)row0 * 1024 + (u.pn - 8) * 256 + wc * 32 + 8 * fq; rstride = 1024; bjstride = 128; }
                else { base = GATES; off0 = (size_t)row0 * 2048 + (u.pn - 12) * 256 + wc * 32 + 8 * fq; rstride = 2048; bjstride = 128; }
#pragma unroll
                for (int ai = 0; ai < 2; ++ai)
#pragma unroll
                    for (int m = 0; m < 4; ++m) { bf16_t* rowp = base + off0 + (size_t)(ai * 128 + m * 16) * rstride;
#pragma unroll
                        for (int bj = 0; bj < 2; ++bj) { const f32x4 v0 = acc[ai][bj][m][0], v1 = acc[ai][bj][m][1];
                            u32x4 w; w.x = pk2(v0[0], v0[1]); w.y = pk2(v0[2], v0[3]); w.z = pk2(v1[0], v1[1]); w.w = pk2(v1[2], v1[3]);
                            *(u32x4*)(rowp + bj * bjstride) = w; } }
            } else if (u.pn < 26) {
                const int b = u.pm >> 4, ck0 = (u.pm & 15) * 4 + wr;
                const int ncol = (u.pn < 22) ? 512 : 1024;
                bf16_t* dst = (u.pn < 22) ? VT : GVT;
                dst += (((size_t)(b * 64 + ck0) * ncol) + ((u.pn < 22) ? (u.pn - 20) : (u.pn - 22)) * 256 + wc * 32 + 8 * fq) * 64 + fr;
#pragma unroll
                for (int ai = 0; ai < 2; ++ai)
#pragma unroll
                    for (int m = 0; m < 4; ++m)
#pragma unroll
                        for (int bj = 0; bj < 2; ++bj)
#pragma unroll
                            for (int n = 0; n < 2; ++n) { const f32x4 v = acc[ai][bj][m][n];
#pragma unroll
                                for (int e = 0; e < 4; ++e) dst[((size_t)(2 * ai) * ncol + bj * 128 + 4 * n + e) * 64 + m * 16] = f2bf(v[e]); }
            } else {
                if (wc == 0 && fq < 2) {
#pragma unroll
                    for (int ai = 0; ai < 2; ++ai)
#pragma unroll
                        for (int m = 0; m < 4; ++m)
#pragma unroll
                            for (int n = 0; n < 2; ++n) *(f32x4*)(GLOW + (size_t)(row0 + ai * 128 + m * 16) * 16 + 8 * fq + 4 * n) = acc[ai][0][m][n];
                }
            }
        } else if constexpr (MODE == E_PMIX) {
            const int col0 = u.pn * 256 + wc * 32 + 8 * fq;
#pragma unroll
            for (int ai = 0; ai < 2; ++ai)
#pragma unroll
                for (int m = 0; m < 4; ++m) { const size_t r = (size_t)(row0 + ai * 128 + m * 16);
#pragma unroll
                    for (int bj = 0; bj < 2; ++bj) {
                        const u32x4 g = *(const u32x4*)(GATES + r * 2048 + 1024 + col0 + bj * 128);
                        const f32x4 v0 = acc[ai][bj][m][0], v1 = acc[ai][bj][m][1];
                        float o[8];
                        o[0] = v0[0] * sigB(bflo(g.x)); o[1] = v0[1] * sigB(bfhi(g.x)); o[2] = v0[2] * sigB(bflo(g.y)); o[3] = v0[3] * sigB(bfhi(g.y));
                        o[4] = v1[0] * sigB(bflo(g.z)); o[5] = v1[1] * sigB(bfhi(g.z)); o[6] = v1[2] * sigB(bflo(g.w)); o[7] = v1[3] * sigB(bfhi(g.w));
                        u32x4 w; w.x = pk2(o[0], o[1]); w.y = pk2(o[2], o[3]); w.z = pk2(o[4], o[5]); w.w = pk2(o[6], o[7]);
                        *(u32x4*)(MIX + r * D + col0 + bj * 128) = w; } }
        } else if constexpr (MODE == E_WOUT || MODE == E_FF2) {
            const int col0 = u.pn * 256 + wc * 32 + 4 * fq;
#pragma unroll
            for (int ai = 0; ai < 2; ++ai)
#pragma unroll
                for (int m = 0; m < 4; ++m) { const size_t r = (size_t)(row0 + ai * 128 + m * 16); float ss = 0.f;
#pragma unroll
                    for (int bj = 0; bj < 2; ++bj)
#pragma unroll
                        for (int n = 0; n < 2; ++n) { const size_t off = r * D + col0 + bj * 128 + n * 16;
                            f32x4 xv;
                            if constexpr (MODE == E_WOUT) xv = *(const f32x4*)(XIN + off);
                            else { const u32x2 xb = *(const u32x2*)(XBIN + off); xv = (f32x4){bflo(xb.x), bfhi(xb.x), bflo(xb.y), bfhi(xb.y)}; }
                            const f32x4 o = xv + acc[ai][bj][m][n];
                            ss += (o[0] * o[0] + o[1] * o[1]) + (o[2] * o[2] + o[3] * o[3]);
                            u32x2 w; w.x = pk2(o[0], o[1]); w.y = pk2(o[2], o[3]); *(u32x2*)(XB + off) = w; }
                    ss += __shfl_xor(ss, 16); ss += __shfl_xor(ss, 32);
                    if (fq == 0) unsafeAtomicAdd(SS + r, ss); }
        } else {
            const int col0 = u.pn * 256 + wc * 32 + 8 * fq;
#pragma unroll
            for (int ai = 0; ai < 2; ++ai)
#pragma unroll
                for (int m = 0; m < 4; ++m) { const size_t r = (size_t)(row0 + ai * 128 + m * 16);
                    const float rs = rsqrtf(SS[r] * (1.f / D) + EPS);
#pragma unroll
                    for (int bj = 0; bj < 2; ++bj) { f32x4 v0 = acc[ai][bj][m][0] * rs, v1 = acc[ai][bj][m][1] * rs;
#pragma unroll
                        for (int e = 0; e < 4; ++e) { const float a = fmaxf(v0[e], 0.f), c = fmaxf(v1[e], 0.f); v0[e] = a * a; v1[e] = c * c; }
                        u32x4 w; w.x = pk2(v0[0], v0[1]); w.y = pk2(v0[2], v0[3]); w.z = pk2(v1[0], v1[1]); w.w = pk2(v1[2], v1[3]);
                        *(u32x4*)(HID + r * FF + col0 + bj * 128) = w; } }
        }
    }
};

struct RevOrder : pg8::StaticOrder {
    __host__ __device__ bool next(int i, pg8::Unit& u) const { const bool r = pg8::StaticOrder::next(i, u); u.pm = nM - 1 - u.pm; return r; }
};
__device__ __forceinline__ int win_src(int n) {
    if (n < 1024) return n;
    if (n < 2048) return n + 512;
    if (n < 3072) return n + 1536;
    if (n < 5120) return n + 1552;
    if (n < 5632) return n - 4096;
    if (n < 6656) return n - 3072;
    if (n < 6672) return n - 2048;
    return -1;
}
__device__ __forceinline__ void transpose_item(const float* W, int K, int Nsrc, bf16_t* WT, int n0, int k0, int kdst, int srccol, const float* kscale, LAS float* scr, int lane) {
#pragma unroll 8
    for (int i = 0; i < 32; ++i) { const int kk = 2 * i + (lane >> 5); float v = 0.f;
        if (srccol >= 0) v = W[(size_t)(k0 + kk) * Nsrc + srccol];
        if (kscale) v *= kscale[k0 + kk];
        scr[kk * 33 + (lane & 31)] = v; }
    LDS_WAIT();
    const int c = lane & 7;
#pragma unroll
    for (int j = 0; j < 4; ++j) { const int n = (lane >> 3) + 8 * j; const LAS float* s = scr + (8 * c) * 33 + n;
        u32x4 o; o.x = pk2(s[0 * 33], s[1 * 33]); o.y = pk2(s[2 * 33], s[3 * 33]); o.z = pk2(s[4 * 33], s[5 * 33]); o.w = pk2(s[6 * 33], s[7 * 33]);
        *(u32x4*)(WT + (size_t)(n0 + n) * K + kdst + 8 * c) = o; }
    LDS_WAIT();
}

__device__ __forceinline__ void sb_tile(const bf16x8 (&kf)[4], const bf16x8 (&va)[4], const bf16x8 (&qf)[4], f32x16& o0, f32x16& o1, float& carry, bool diag, int l32, int hi) {
    f32x16 z;
#pragma unroll
    for (int r = 0; r < 16; ++r) z[r] = 0.f;
#pragma unroll
    for (int st = 0; st < 4; ++st) z = __builtin_amdgcn_mfma_f32_32x32x16_bf16(kf[st], qf[st], z, 0, 0, 0);
    float wv[16]; float run = 1.f;
#pragma unroll
    for (int r = 15; r >= 0; --r) {
        const float zz = z[r] * 0.125f, tt = __expf(-fabsf(zz)), rr = __builtin_amdgcn_rcpf(1.f + tt), b2 = tt * rr;
        float beta = zz >= 0.f ? rr : b2, fail = zz >= 0.f ? b2 : rr;
        if (diag) { const bool valid = (16 * hi + r < l32); beta = valid ? beta : 0.f; fail = valid ? fail : 1.f; }
        wv[r] = beta * run; run *= fail;
    }
    const float other = __shfl_xor(run, 32);
    const float add = carry * (hi == 0 ? other : 1.f);
#pragma unroll
    for (int r = 0; r < 16; ++r) wv[r] *= add;
    carry *= run * other;
    const bf16x8 pb0 = pack8(wv[0], wv[1], wv[2], wv[3], wv[4], wv[5], wv[6], wv[7]);
    const bf16x8 pb1 = pack8(wv[8], wv[9], wv[10], wv[11], wv[12], wv[13], wv[14], wv[15]);
    o0 = __builtin_amdgcn_mfma_f32_32x32x16_bf16(va[0], pb0, o0, 0, 0, 0);
    o0 = __builtin_amdgcn_mfma_f32_32x32x16_bf16(va[1], pb1, o0, 0, 0, 0);
    o1 = __builtin_amdgcn_mfma_f32_32x32x16_bf16(va[2], pb0, o1, 0, 0, 0);
    o1 = __builtin_amdgcn_mfma_f32_32x32x16_bf16(va[3], pb1, o1, 0, 0, 0);
}
__device__ __forceinline__ void sb_attn_unit(const bf16_t* __restrict__ QH, const bf16_t* __restrict__ KH, const bf16_t* __restrict__ VT, bf16_t* __restrict__ OSB, int b, int h, int qt, int lane_) {
    int lane = lane_; asm volatile("" : "+v"(lane));
    const int l32 = lane & 31, hi = lane >> 5, t0 = qt * 32;
    const size_t rowb = (size_t)b * SEQ;
    const size_t hb = (size_t)(b * 8 + h) * SEQ;
    const bf16_t* qrow = QH + (hb + t0 + l32) * 64 + 8 * hi;
    bf16x8 qf[4];
#pragma unroll
    for (int st = 0; st < 4; ++st) qf[st] = *(const bf16x8*)(qrow + 16 * st);
    f32x16 o0, o1;
#pragma unroll
    for (int r = 0; r < 16; ++r) { o0[r] = 0.f; o1[r] = 0.f; }
    float carry = 1.f;
    const int kperm = 16 * ((l32 >> 2) & 1) + (l32 & 3) + 4 * (l32 >> 3);
    bf16x8 k0[4], v0[4], k1[4], v1[4], k2[4], v2[4];
#define SB_LOAD(KF, VA, s0_) do { const bf16_t* krow_ = KH + (hb + (s0_) + kperm) * 64 + 8 * hi; \
        const bf16_t* vb_ = VT + (((size_t)(b * 64 + ((s0_) >> 6)) * 512 + h * 64 + l32) * 64 + ((s0_) & 63) + 16 * hi); \
        _Pragma("unroll") for (int st = 0; st < 4; ++st) KF[st] = *(const bf16x8*)(krow_ + 16 * st); \
        VA[0] = *(const bf16x8*)(vb_); VA[1] = *(const bf16x8*)(vb_ + 8); VA[2] = *(const bf16x8*)(vb_ + 32 * 64); VA[3] = *(const bf16x8*)(vb_ + 32 * 64 + 8); } while (0)
#define SB_STEP(KC, VC, KP, VP, DIAG) { { const int sp_ = s0 >= 64 ? s0 - 64 : 0; SB_LOAD(KP, VP, sp_); }     \
        sb_tile(KC, VC, qf, o0, o1, carry, DIAG, l32, hi); if (s0 < 32 || __all(carry == 0.f)) break; s0 -= 32; }
    SB_LOAD(k0, v0, t0);
    { const int sp_ = t0 >= 32 ? t0 - 32 : 0; SB_LOAD(k1, v1, sp_); }
    for (int s0 = t0; ; ) {
        SB_STEP(k0, v0, k2, v2, s0 == t0)
        SB_STEP(k1, v1, k0, v0, false)
        SB_STEP(k2, v2, k1, v1, false)
    }
#undef SB_STEP
#undef SB_LOAD
    bf16_t* orow = OSB + (rowb + t0 + l32) * 1536 + h * 64 + 4 * hi;
#pragma unroll
    for (int g = 0; g < 4; ++g) {
        u32x2 w0, w1; w0.x = pk2_v(o0[4 * g], o0[4 * g + 1]); w0.y = pk2_v(o0[4 * g + 2], o0[4 * g + 3]); w1.x = pk2_v(o1[4 * g], o1[4 * g + 1]); w1.y = pk2_v(o1[4 * g + 2], o1[4 * g + 3]);
        *(u32x2*)(orow + 8 * g) = w0; *(u32x2*)(orow + 32 + 8 * g) = w1;
    }
}

__device__ __forceinline__ void split_hl(float a, float b, unsigned& h, unsigned& l) { h = pk2(a, b); l = pk2(a - bflo(h), b - bfhi(h)); }
__device__ __forceinline__ void split8(float v0, float v1, float v2, float v3, float v4, float v5, float v6, float v7, bf16x8& hv, bf16x8& lv) {
    unsigned h0, h1, h2, h3, l0, l1, l2, l3; split_hl(v0, v1, h0, l0); split_hl(v2, v3, h1, l1); split_hl(v4, v5, h2, l2); split_hl(v6, v7, h3, l3);
    u32x4 ph, pl; ph.x = h0; ph.y = h1; ph.z = h2; ph.w = h3; pl.x = l0; pl.y = l1; pl.z = l2; pl.w = l3; hv = __builtin_bit_cast(bf16x8, ph); lv = __builtin_bit_cast(bf16x8, pl); }
__device__ __forceinline__ void gla_prep_unit(LAS bf16_t* lq, bf16_t* GQ, bf16_t* GK, const float* __restrict__ GLOW, const float* __restrict__ Wgu, const float* __restrict__ bgu, bf16_t* __restrict__ KT, float* __restrict__ ED, int bh, int chunk, int cb, int lane_) {
    int lane = lane_; asm volatile("" : "+v"(lane));
    const int b = bh >> 2, h = bh & 3, l32 = lane & 31, hi = lane >> 5, c = 32 * cb + l32;
    const size_t tok0 = (size_t)b * SEQ + chunk * 64;
    bf16x8 wh, wl;
    { float wv[8];
#pragma unroll
      for (int j = 0; j < 8; ++j) wv[j] = Wgu[(8 * hi + j) * 512 + h * 128 + c];
      split8(wv[0], wv[1], wv[2], wv[3], wv[4], wv[5], wv[6], wv[7], wh, wl); }
    const float bg = bgu[h * 128 + c];
    const size_t tile = ((size_t)bh * 64 + chunk) * 8192;
    bf16_t* pt = KT + tile + c * 64 + 4 * hi;
    LAS bf16_t* lk = lq + 64 * 40;
    u32x4 gq4[4], gk4[4];
#pragma unroll
    for (int j = 0; j < 4; ++j) { const int idx = lane + 64 * j, row = idx >> 2, part = idx & 3; const size_t o_ = tile + (size_t)row * 128 + cb * 32 + part * 8;
        gq4[j] = *(const u32x4*)(GQ + o_); gk4[j] = *(const u32x4*)(GK + o_); }
    bf16x8 ltri[2], lone;
#pragma unroll
    for (int op = 0; op < 2; ++op)
#pragma unroll
        for (int j = 0; j < 8; ++j) { const int r = 8 * op + j, tp = (r & 3) + 8 * (r >> 2) + 4 * hi; ltri[op][j] = (tp <= l32) ? (short)0x3F80 : (short)0; }
#pragma unroll
    for (int j = 0; j < 8; ++j) lone[j] = (short)0x3F80;
    f32x16 la[2];
#pragma unroll
    for (int tb = 0; tb < 2; ++tb) {
        const float* gp = GLOW + (tok0 + 32 * tb + l32) * 16 + 8 * hi;
        const f32x4 g0 = *(const f32x4*)gp, g1 = *(const f32x4*)(gp + 4);
        bf16x8 ahv, alv; split8(g0[0], g0[1], g0[2], g0[3], g1[0], g1[1], g1[2], g1[3], ahv, alv);
        f32x16 x;
#pragma unroll
        for (int r = 0; r < 16; ++r) x[r] = bg;
        x = __builtin_amdgcn_mfma_f32_32x32x16_bf16(alv, wh, x, 0, 0, 0);
        x = __builtin_amdgcn_mfma_f32_32x32x16_bf16(ahv, wl, x, 0, 0, 0);
        x = __builtin_amdgcn_mfma_f32_32x32x16_bf16(ahv, wh, x, 0, 0, 0);
#pragma unroll
        for (int r = 0; r < 16; ++r) la[tb][r] = -softplus(-x[r]) * (1.f / 16.f);
    }
    bf16x8 bhv[2][2], blv[2][2];
#pragma unroll
    for (int tb = 0; tb < 2; ++tb)
#pragma unroll
        for (int op = 0; op < 2; ++op) split8(la[tb][8 * op], la[tb][8 * op + 1], la[tb][8 * op + 2], la[tb][8 * op + 3], la[tb][8 * op + 4], la[tb][8 * op + 5], la[tb][8 * op + 6], la[tb][8 * op + 7], bhv[tb][op], blv[tb][op]);
    f32x16 bc[2];
#pragma unroll
    for (int tb = 0; tb < 2; ++tb) {
#pragma unroll
        for (int r = 0; r < 16; ++r) bc[tb][r] = 0.f;
#pragma unroll
        for (int op = 0; op < 2; ++op) {
            bc[tb] = __builtin_amdgcn_mfma_f32_32x32x16_bf16(ltri[op], blv[tb][op], bc[tb], 0, 0, 0);
            bc[tb] = __builtin_amdgcn_mfma_f32_32x32x16_bf16(ltri[op], bhv[tb][op], bc[tb], 0, 0, 0);
        }
    }
#pragma unroll
    for (int op = 0; op < 2; ++op) {
        bc[1] = __builtin_amdgcn_mfma_f32_32x32x16_bf16(lone, blv[0][op], bc[1], 0, 0, 0);
        bc[1] = __builtin_amdgcn_mfma_f32_32x32x16_bf16(lone, bhv[0][op], bc[1], 0, 0, 0);
    }
#pragma unroll
    for (int j = 0; j < 4; ++j) { const int idx = lane + 64 * j, row = idx >> 2, part = idx & 3; *(LAS u32x4*)(lq + row * 40 + part * 8) = gq4[j]; *(LAS u32x4*)(lk + row * 40 + part * 8) = gk4[j]; }
    LDS_WAIT();
    const float t63 = __shfl(bc[1][15], 32 + l32);
#pragma unroll
    for (int tb = 0; tb < 2; ++tb)
#pragma unroll
        for (int g4 = 0; g4 < 4; ++g4) {
            float kh[4];
#pragma unroll
            for (int e = 0; e < 4; ++e) { const int r = 4 * g4 + e, t = 32 * tb + 8 * g4 + 4 * hi + e;
                const float bcv = bc[tb][r], ee = fexp(bcv), ei = fexp(-bcv);
                const float qv = bf2f(lq[t * 40 + l32]), kv = bf2f(lk[t * 40 + l32]);
                kh[e] = kv * ei;
                lq[t * 40 + l32] = f2bf(qv * 0.08838834764831845f * ee); lk[t * 40 + l32] = f2bf(kh[e]); }
            u32x2 w; w.x = pk2(kh[0], kh[1]); w.y = pk2(kh[2], kh[3]);
            *(u32x2*)(pt + 32 * tb + 8 * g4) = w;
        }
    if (hi == 0) ED[((size_t)bh * 64 + chunk) * 128 + c] = fexp(t63);
    LDS_WAIT();
#pragma unroll
    for (int j = 0; j < 4; ++j) { const int idx = lane + 64 * j, row = idx >> 2, part = idx & 3; const size_t o_ = tile + (size_t)row * 128 + cb * 32 + part * 8;
        *(u32x4*)(GQ + o_) = *(const LAS u32x4*)(lq + row * 40 + part * 8); *(u32x4*)(GK + o_) = *(const LAS u32x4*)(lk + row * 40 + part * 8); }
    LDS_WAIT();
}

__device__ __forceinline__ void gla_state_block(LAS unsigned char* lds, const bf16_t* __restrict__ KT, const bf16_t* __restrict__ GVT, const float* __restrict__ ED, float* __restrict__ SLOC, float* __restrict__ DSEG, int bh, int seg) {
    int tid_ = threadIdx.x; asm volatile("" : "+v"(tid_));
    const int tid = tid_, lane = tid & 63, w = __builtin_amdgcn_readfirstlane(tid >> 6), l32 = lane & 31, hi = lane >> 5, b = bh >> 2, h = bh & 3;
    f32x16 S[4];
#pragma unroll
    for (int kt = 0; kt < 4; ++kt)
#pragma unroll
        for (int r = 0; r < 16; ++r) S[kt][r] = 0.f;
    bf16x8 vnx[4]; u32x4 ktn[2]; float edn = 0.f, dprod = 1.f;
#define GLA_ALOADS(chx) do { const size_t ck_ = (size_t)bh * 64 + seg * 8 + (chx); \
        { const bf16_t* vp_ = GVT + (((size_t)b * 64 + seg * 8 + (chx)) * 1024 + h * 256 + 32 * w + l32) * 64 + 8 * hi; _Pragma("unroll") for (int st = 0; st < 4; ++st) vnx[st] = *(const bf16x8*)(vp_ + 16 * st); } \
        _Pragma("unroll") for (int i = 0; i < 2; ++i) ktn[i] = *(const u32x4*)(KT + ck_ * 8192 + (size_t)(tid + 512 * i) * 8); \
        if (tid < 128) edn = ED[ck_ * 128 + tid]; } while (0)
    GLA_ALOADS(0);
    for (int ch = 0; ch < 8; ++ch) {
        LAS bf16_t* KTT = (LAS bf16_t*)(lds + (ch & 1) * 18432); LAS float* EDEC = (LAS float*)(lds + 36864 + (ch & 1) * 512);
#pragma unroll
        for (int i = 0; i < 2; ++i) { const int id = tid + 512 * i; *(LAS u32x4*)(KTT + (id >> 3) * 72 + (id & 7) * 8) = ktn[i]; }
        if (tid < 128) { EDEC[tid] = edn; dprod *= edn; }
        bf16x8 vreg[4];
#pragma unroll
        for (int st = 0; st < 4; ++st) vreg[st] = vnx[st];
        if (ch < 7) GLA_ALOADS(ch + 1);
        __builtin_amdgcn_sched_barrier(0);
        LDS_BARRIER();
#pragma unroll
        for (int kt = 0; kt < 4; ++kt) {
#pragma unroll
            for (int st = 0; st < 4; ++st) { const bf16x8 av = *(const LAS bf16x8*)(KTT + (32 * kt + l32) * 72 + 16 * st + 8 * hi);
                S[kt] = __builtin_amdgcn_mfma_f32_32x32x16_bf16(av, vreg[st], S[kt], 0, 0, 0); }
#pragma unroll
            for (int gq = 0; gq < 4; ++gq) { const f32x4 d4 = *(const LAS f32x4*)(EDEC + 32 * kt + 8 * gq + 4 * hi);
#pragma unroll
                for (int e = 0; e < 4; ++e) S[kt][4 * gq + e] *= d4[e]; }
        }
    }
#undef GLA_ALOADS
    float* sl = SLOC + (((size_t)(bh * 7 + seg) * 8 + w) * 64) * 64 + lane;
#pragma unroll
    for (int kt = 0; kt < 4; ++kt)
#pragma unroll
        for (int r = 0; r < 16; ++r) sl[(size_t)(kt * 16 + r) * 64] = S[kt][r];
    if (tid < 128) DSEG[(bh * 8 + seg) * 128 + tid] = dprod;
    LDS_BARRIER();
}

constexpr int G_QT = 0, G_KH = 17408, G_KTT = 34816, G_SC = 53248, G_EDEC = 62464, G_OS = 62976, G_GN = 130560;
struct GlaPtrs { const bf16_t* GQ; const bf16_t* GK; const bf16_t* GO; const bf16_t* GVT; const bf16_t* KT; const float* ED; const float* gn; bf16_t* OGLA; const float* SLOC; const float* DSEG; };

__device__ __forceinline__ void gla_out_unit(LAS unsigned char* lds, const GlaPtrs& g, int bh, int seg) {
    int tid_ = threadIdx.x; asm volatile("" : "+v"(tid_));
    const int tid = tid_, lane = tid & 63, w = __builtin_amdgcn_readfirstlane(tid >> 6), l32 = lane & 31, hi = lane >> 5;
    const int b = bh >> 2, h = bh & 3;
    LAS bf16_t* QT = (LAS bf16_t*)(lds + G_QT); LAS bf16_t* KH = (LAS bf16_t*)(lds + G_KH); LAS bf16_t* KTT = (LAS bf16_t*)(lds + G_KTT); LAS bf16_t* SC = (LAS bf16_t*)(lds + G_SC);
    LAS float* EDEC = (LAS float*)(lds + G_EDEC); LAS float* OS = (LAS float*)(lds + G_OS);
    f32x16 S[4];
#pragma unroll
    for (int kt = 0; kt < 4; ++kt)
#pragma unroll
        for (int r = 0; r < 16; ++r) S[kt][r] = 0.f;
    if (seg > 0) {
        LAS float* DST = OS;
        for (int i = tid; i < seg * 128; i += 512) DST[i] = g.DSEG[(bh * 8) * 128 + i];
        LDS_BARRIER();
        for (int j = 0; j < seg; ++j) {
            const float* sl = g.SLOC + (((size_t)(bh * 7 + j) * 8 + w) * 64) * 64 + lane;
#pragma unroll
            for (int kt = 0; kt < 4; ++kt)
#pragma unroll
                for (int gq = 0; gq < 4; ++gq) { const f32x4 d4 = *(const LAS f32x4*)(DST + j * 128 + 32 * kt + 8 * gq + 4 * hi);
#pragma unroll
                    for (int e = 0; e < 4; ++e) S[kt][4 * gq + e] = S[kt][4 * gq + e] * d4[e] + sl[(size_t)(kt * 16 + 4 * gq + e) * 64]; }
        }
        LDS_BARRIER();
    }
    bf16x8 vreg[4]; u32x4 qn[2], kn[2], ktn[2]; float edn = 0.f;
    LAS float* GN = (LAS float*)(lds + G_GN);
    LAS bf16_t* OSB2 = (LAS bf16_t*)(lds + G_OS);
    if (tid < 256) GN[tid] = g.gn[tid];
    const bool j1first = ((w & 1) == 0);
#define GLA_LOADS(chx) do { const size_t ck_ = (size_t)bh * 64 + seg * 8 + (chx); \
        _Pragma("unroll") for (int i = 0; i < 2; ++i) { const size_t o_ = ck_ * 8192 + (size_t)(tid + 512 * i) * 8; \
            qn[i] = *(const u32x4*)(g.GQ + o_); kn[i] = *(const u32x4*)(g.GK + o_); ktn[i] = *(const u32x4*)(g.KT + o_); } \
        edn = g.ED[ck_ * 128 + (tid & 127)]; } while (0)
#define GLA_VLOAD(chx) do { const bf16_t* vp_ = g.GVT + (((size_t)b * 64 + seg * 8 + (chx)) * 1024 + h * 256 + 32 * w + l32) * 64 + 8 * hi; _Pragma("unroll") for (int st = 0; st < 4; ++st) vreg[st] = *(const bf16x8*)(vp_ + 16 * st); } while (0)
    GLA_LOADS(0); GLA_VLOAD(0);
    for (int ch = 0; ch <= 8; ++ch) {
        const bool has = ch < 8;
        const int cp = ch > 0 ? ch - 1 : 0;
        const size_t tokp = (size_t)b * SEQ + seg * 512 + cp * 64;
        if (has) {
#pragma unroll
            for (int i = 0; i < 2; ++i) { const int id = tid + 512 * i;
                *(LAS u32x4*)(QT + (id >> 4) * 136 + (id & 15) * 8) = qn[i]; *(LAS u32x4*)(KH + (id >> 4) * 136 + (id & 15) * 8) = kn[i]; *(LAS u32x4*)(KTT + (id >> 3) * 72 + (id & 7) * 8) = ktn[i]; }
            if (tid < 128) EDEC[tid] = edn;
            GLA_LOADS(ch < 7 ? ch + 1 : 7);
        }
        __builtin_amdgcn_sched_barrier(0);
        LDS_BARRIER();
        if (has) {
            const int l16 = lane & 15, q4 = lane >> 4, ti = w >> 1;
#pragma unroll
            for (int sjj = 0; sjj < 2; ++sjj) { const int sj = 2 * (w & 1) + sjj; f32x4 a4 = (f32x4){0.f, 0.f, 0.f, 0.f};
#pragma unroll
                for (int kk = 0; kk < 4; ++kk) { const bf16x8 av = *(const LAS bf16x8*)(KH + (16 * sj + l16) * 136 + 32 * kk + 8 * q4); const bf16x8 bv = *(const LAS bf16x8*)(QT + (16 * ti + l16) * 136 + 32 * kk + 8 * q4);
                    a4 = __builtin_amdgcn_mfma_f32_16x16x32_bf16(av, bv, a4, 0, 0, 0); }
                const int tt_ = 16 * ti + l16, ss_ = 16 * sj + 4 * q4;
                u32x2 wv; wv.x = pk2(ss_ <= tt_ ? a4[0] : 0.f, ss_ + 1 <= tt_ ? a4[1] : 0.f); wv.y = pk2(ss_ + 2 <= tt_ ? a4[2] : 0.f, ss_ + 3 <= tt_ ? a4[3] : 0.f);
                *(LAS u32x2*)(SC + tt_ * 72 + ss_) = wv; }
        }
        LDS_BARRIER();
        auto J1 = [&]() __attribute__((always_inline)) {
            {
                if (has) {
                    LAS bf16_t* ob = OSB2 + (ch & 1) * (64 * 264) + 32 * w + l32;
#pragma unroll 1
                    for (int tt = 0; tt < 2; ++tt) {
                        f32x16 o;
#pragma unroll
                        for (int r = 0; r < 16; ++r) o[r] = 0.f;
#pragma unroll
                        for (int kt = 0; kt < 4; ++kt)
#pragma unroll
                            for (int op = 0; op < 2; ++op) {
                                const bf16x8 bs = pack8(S[kt][8 * op], S[kt][8 * op + 1], S[kt][8 * op + 2], S[kt][8 * op + 3], S[kt][8 * op + 4], S[kt][8 * op + 5], S[kt][8 * op + 6], S[kt][8 * op + 7]);
                                const LAS bf16_t* ap = QT + (32 * tt + l32) * 136 + 32 * kt + 16 * op + 4 * hi;
                                const u32x2 a0 = *(const LAS u32x2*)ap, a1 = *(const LAS u32x2*)(ap + 8);
                                u32x4 aw; aw.x = a0.x; aw.y = a0.y; aw.z = a1.x; aw.w = a1.y;
                                o = __builtin_amdgcn_mfma_f32_32x32x16_bf16(__builtin_bit_cast(bf16x8, aw), bs, o, 0, 0, 0); }
#pragma unroll
                        for (int st = 0; st < 4; ++st) { const bf16x8 av = *(const LAS bf16x8*)(SC + (32 * tt + l32) * 72 + 16 * st + 8 * hi);
                            o = __builtin_amdgcn_mfma_f32_32x32x16_bf16(av, vreg[st], o, 0, 0, 0); }
#pragma unroll
                        for (int r = 0; r < 16; ++r) ob[(32 * tt + (r & 3) + 8 * (r >> 2) + 4 * hi) * 264] = f2bf_v(o[r]);
                    }
#pragma unroll
                    for (int kt = 0; kt < 4; ++kt) {
#pragma unroll
                        for (int st = 0; st < 4; ++st) { const bf16x8 av = *(const LAS bf16x8*)(KTT + (32 * kt + l32) * 72 + 16 * st + 8 * hi);
                            S[kt] = __builtin_amdgcn_mfma_f32_32x32x16_bf16(av, vreg[st], S[kt], 0, 0, 0); }
#pragma unroll
                        for (int gq = 0; gq < 4; ++gq) { const f32x4 d4 = *(const LAS f32x4*)(EDEC + 32 * kt + 8 * gq + 4 * hi);
#pragma unroll
                            for (int e = 0; e < 4; ++e) S[kt][4 * gq + e] *= d4[e]; }
                    }
                    GLA_VLOAD(ch < 7 ? ch + 1 : 7);
                }
            }
        };
        auto J2 = [&]() __attribute__((always_inline)) {
            {
                if (ch > 0) {
                    const int t = tid >> 3, part = tid & 7;
                    u32x4 gocur[4];
                    { const bf16_t* gop_ = g.GO + (tokp + t) * 1024 + h * 256 + 32 * part;
#pragma unroll
                      for (int i = 0; i < 4; ++i) gocur[i] = *(const u32x4*)(gop_ + 8 * i); }
                    const LAS u32x4* op4 = (const LAS u32x4*)(OSB2 + (cp & 1) * (64 * 264) + t * 264 + 32 * part);
                    float ss = 0.f;
#pragma unroll
                    for (int i = 0; i < 4; ++i) { const u32x4 x = op4[i];
                        ss += (bflo(x.x) * bflo(x.x) + bfhi(x.x) * bfhi(x.x)) + (bflo(x.y) * bflo(x.y) + bfhi(x.y) * bfhi(x.y)) + (bflo(x.z) * bflo(x.z) + bfhi(x.z) * bfhi(x.z)) + (bflo(x.w) * bflo(x.w) + bfhi(x.w) * bfhi(x.w)); }
                    ss += __shfl_xor(ss, 1); ss += __shfl_xor(ss, 2); ss += __shfl_xor(ss, 4);
                    const float rs = rsqrtf(ss * (1.f / 256.f) + EPS);
                    bf16_t* dst = g.OGLA + (tokp + t) * 1536 + 512 + h * 256 + 32 * part; const LAS float* gnp = GN + 32 * part;
#pragma unroll
                    for (int i = 0; i < 4; ++i) { const u32x4 gw = gocur[i]; const u32x4 x = op4[i];
                        const float v[8] = {bflo(x.x), bfhi(x.x), bflo(x.y), bfhi(x.y), bflo(x.z), bfhi(x.z), bflo(x.w), bfhi(x.w)};
                        const f32x4 n0 = *(const LAS f32x4*)(gnp + 8 * i), n1 = *(const LAS f32x4*)(gnp + 8 * i + 4);
                        float gv[8] = {bflo(gw.x), bfhi(gw.x), bflo(gw.y), bfhi(gw.y), bflo(gw.z), bfhi(gw.z), bflo(gw.w), bfhi(gw.w)}; float ov[8];
#pragma unroll
                        for (int e = 0; e < 4; ++e) { ov[e] = v[e] * rs * n0[e] * (gv[e] * sigmoidf(gv[e])); ov[4 + e] = v[4 + e] * rs * n1[e] * (gv[4 + e] * sigmoidf(gv[4 + e])); }
                        u32x4 wv; wv.x = pk2(ov[0], ov[1]); wv.y = pk2(ov[2], ov[3]); wv.z = pk2(ov[4], ov[5]); wv.w = pk2(ov[6], ov[7]);
                        *(u32x4*)(dst + 8 * i) = wv; }
                }
            }
        };
        if (j1first) { J1(); J2(); } else { J2(); J1(); }
        LDS_BARRIER();
    }
#undef GLA_LOADS
#undef GLA_VLOAD
    LDS_BARRIER();
}


#define XB_TMO      128
#define XB_XCNT(j)  (256  + 64 * (j))
#define XB_XSUB(j)  (1280 + 64 * (j))
#define XB_XGEN(j)  (2304 + 64 * (j))
#define XB_TOP      3328
#define XB_TOPGEN   3392
#define XCD_BAR_WORDS 3456
#define XB_SPIN_CAP (1u << 18)

__device__ __forceinline__ unsigned xb_ld(unsigned* p)              { return __hip_atomic_load(p, __ATOMIC_RELAXED, __HIP_MEMORY_SCOPE_AGENT); }
__device__ __forceinline__ unsigned xb_add(unsigned* p, unsigned v) { return __hip_atomic_fetch_add(p, v, __ATOMIC_RELAXED, __HIP_MEMORY_SCOPE_AGENT); }
__device__ __forceinline__ unsigned xb_xcc_id() { return (unsigned)__builtin_amdgcn_s_getreg((3 << 11) | 20) & 0xFu; }
#define XB_SPIN(cond, bar) do { unsigned _sp = 0; while (cond) { __builtin_amdgcn_s_sleep(1); \
    if ((++_sp & 255u) == 0u) { if (xb_ld(&(bar)[XB_TMO])) break; if (_sp > XB_SPIN_CAP) { atomicAdd(&(bar)[XB_TMO], 1u); break; } } } } while (0)

struct XcdBarrier {
    unsigned* bar; unsigned x;
    volatile LAS unsigned* st;
};

__device__ __forceinline__ XcdBarrier xcd_barrier_post(unsigned* bar, volatile LAS unsigned* st) {
    XcdBarrier b; b.bar = bar; b.x = xb_xcc_id(); b.st = st;
    if (threadIdx.x == 0) (void)xb_add(&bar[XB_XCNT(b.x)], 1u);
    return b;
}
__device__ __forceinline__ void xcd_barrier_complete(unsigned* bar, unsigned x, unsigned& nloc, unsigned& nx) {
    const unsigned G = gridDim.x * gridDim.y * gridDim.z;
    unsigned sum, cnt, mine, sp = 0u;
    for (;;) {
        sum = 0u; cnt = 0u; mine = 0u;
#pragma unroll
        for (unsigned j = 0; j < 16; ++j) { const unsigned c = xb_ld(&bar[XB_XCNT(j)]); sum += c; cnt += (c > 0u) ? 1u : 0u; mine = (j == x) ? c : mine; }
        if (sum == G) break;
        __builtin_amdgcn_s_sleep(1);
        if ((++sp & 255u) == 0u) { if (xb_ld(&bar[XB_TMO])) break; if (sp > XB_SPIN_CAP) { atomicAdd(&bar[XB_TMO], 1u); break; } }
    }
    nloc = mine > 0u ? mine : 1u; nx = cnt > 0u ? cnt : 1u;
}

__device__ __forceinline__ void xcd_barrier(const XcdBarrier& b) {
    asm volatile("s_waitcnt vmcnt(0)" ::: "memory");
    __syncthreads();
    if (threadIdx.x == 0) {
        unsigned* bar = b.bar;
        __builtin_amdgcn_s_waitcnt(0);
        unsigned nloc = b.st[0], nx = b.st[1];
        if (nloc == 0u) { xcd_barrier_complete(bar, b.x, nloc, nx); b.st[0] = nloc; b.st[1] = nx; }
        const unsigned old = xb_add(&bar[XB_XSUB(b.x)], 1u);
        const unsigned gen = old / nloc;
        if (old + 1u == (gen + 1u) * nloc) {
            __builtin_amdgcn_fence(__ATOMIC_RELEASE, "agent");
            asm volatile("s_waitcnt vmcnt(0)" ::: "memory");
            const unsigned og = xb_add(&bar[XB_TOP], 1u);
            const unsigned tg = og / nx;
            if (og + 1u == (tg + 1u) * nx) xb_add(&bar[XB_TOPGEN], 1u);
            else XB_SPIN(xb_ld(&bar[XB_TOPGEN]) == tg, bar);
            __builtin_amdgcn_fence(__ATOMIC_ACQUIRE, "agent");
            xb_add(&bar[XB_XGEN(b.x)], 1u);
            asm volatile("s_waitcnt vmcnt(0)" ::: "memory");
        } else {
            XB_SPIN(xb_ld(&bar[XB_XGEN(b.x)]) == gen, bar);
            __builtin_amdgcn_fence(__ATOMIC_ACQUIRE, "agent");
            asm volatile("s_waitcnt vmcnt(0)" ::: "memory");
        }
    }
    __syncthreads();
}

struct Args { const float* in[13]; float* out; unsigned char* ws; };
__global__ void __launch_bounds__(512, 2) fwd_kernel(Args a) {
    extern __shared__ __attribute__((aligned(16))) unsigned char lds_raw[];
    LAS unsigned char* lds = (LAS unsigned char*)lds_raw;
    cg::grid_group grid = cg::this_grid();
    volatile LAS unsigned* MISC = (volatile LAS unsigned*)(lds + MISC_OFF);
    if (threadIdx.x < 4) MISC[threadIdx.x] = 0u;
    __syncthreads();
    unsigned* barw = (unsigned*)(a.ws + WS_BAR);
#define PHASE_IDS() int tid_ = threadIdx.x; asm volatile("" : "+v"(tid_)); const int tid = tid_, lane = tid & 63, wave = __builtin_amdgcn_readfirstlane(tid >> 6), gw = bid * 8 + wave, NGW = G * 8; (void)tid; (void)lane; (void)gw; (void)NGW
    const int G = gridDim.x, bid = blockIdx.x;
    unsigned char* ws = a.ws; unsigned char* dout = (unsigned char*)a.out;
    const float* x = a.in[0];
    float* SS1 = (float*)(ws + WS_SS1); float* SS2 = (float*)(ws + WS_SS2); float* DSEG = (float*)(ws + WS_DSEG); float* ED = (float*)(ws + WS_ED); bf16_t* KT = (bf16_t*)(ws + WS_KT); float* GLOW = (float*)(ws + WS_GLOW);
    bf16_t* WinT = (bf16_t*)(ws + WS_WIN); bf16_t* WpcT = (bf16_t*)(ws + WS_WPA); bf16_t* WoutT = (bf16_t*)(ws + WS_WOUT);
    bf16_t* W1T = (bf16_t*)(ws + WS_W1); bf16_t* W2T = (bf16_t*)(ws + WS_W2);
    bf16_t* HB = (bf16_t*)(ws + WS_HB); bf16_t* OC = (bf16_t*)(ws + WS_OC); bf16_t* GO = (bf16_t*)(dout + DO_GO); bf16_t* GATES = (bf16_t*)(ws + WS_GATES); bf16_t* GQ = (bf16_t*)(ws + WS_GQ); bf16_t* GK = (bf16_t*)(ws + WS_GK);
    bf16_t* QH = (bf16_t*)(ws + WS_QH); bf16_t* KH = (bf16_t*)(ws + WS_KH); bf16_t* HID = (bf16_t*)(ws + WS_HID); float* SLOC = (float*)(ws + WS_SLOC);
    bf16_t* GVT = (bf16_t*)(dout + DO_GVT); bf16_t* VT = (bf16_t*)(ws + WS_VT); bf16_t* MIX = (bf16_t*)(dout + DO_GVT);

    {
        PHASE_IDS();
        for (int i = bid * 512 + tid; i < T; i += G * 512) { SS1[i] = 0.f; SS2[i] = 0.f; }
        if (bid == 0) for (int i = tid; i < XCD_BAR_WORDS; i += 512) __hip_atomic_store(barw + i, 0u, __ATOMIC_RELAXED, __HIP_MEMORY_SCOPE_AGENT);
        LAS float* scr = (LAS float*)(lds + wave * 16384);
        constexpr int I_IN = 16 * (NWIN / 32);
        for (int r = gw; r < I_IN; r += NGW) { const int nb = r % (NWIN / 32), kb = r / (NWIN / 32); transpose_item(a.in[2], D, DIN, WinT, 32 * nb, 64 * kb, 64 * kb, win_src(32 * nb + (lane & 31)), nullptr, scr, lane); }
        const float* gmix = a.in[1];
        for (int m0 = gw * 8; m0 < T; m0 += NGW * 8) {
            f32x4 v[8][4]; float sq[8];
#pragma unroll
            for (int rr = 0; rr < 8; ++rr) { const f32x4* xr = (const f32x4*)(x + (size_t)(m0 + rr) * D) + lane;
#pragma unroll
                for (int j = 0; j < 4; ++j) v[rr][j] = __builtin_nontemporal_load(xr + 64 * j); }
#pragma unroll
            for (int rr = 0; rr < 8; ++rr) { float s = 0.f;
#pragma unroll
                for (int j = 0; j < 4; ++j) s += (v[rr][j][0] * v[rr][j][0] + v[rr][j][1] * v[rr][j][1]) + (v[rr][j][2] * v[rr][j][2] + v[rr][j][3] * v[rr][j][3]);
                sq[rr] = rsqrtf(wave_sum(s) * (1.f / D) + EPS); }
#pragma unroll
            for (int j = 0; j < 4; ++j) { const f32x4 gg = ((const f32x4*)gmix)[lane + 64 * j];
#pragma unroll
                for (int rr = 0; rr < 8; ++rr) { u32x2 w; w.x = pk2(v[rr][j][0] * sq[rr] * gg[0], v[rr][j][1] * sq[rr] * gg[1]); w.y = pk2(v[rr][j][2] * sq[rr] * gg[2], v[rr][j][3] * sq[rr] * gg[3]);
                    ((u32x2*)(HB + (size_t)(m0 + rr) * D))[lane + 64 * j] = w; } }
        }
    }
    grid.sync();
    const XcdBarrier xbar = xcd_barrier_post(barw, MISC);

    {
        pg8::Gemm g{HB, WinT, T, NWIN, D}; pg8::StaticOrder S; S.init(T, NWIN, G, bid);
        Epi<E_INPROJ> E{}; E.QH = QH; E.KH = KH; E.GQ = GQ; E.GK = GK; E.GO = GO; E.GATES = GATES; E.VT = VT; E.GVT = GVT; E.GLOW = GLOW;
        pg8::gemm_phase<Epi<E_INPROJ>, pg8::StaticOrder, true, true>(lds, g, S, E);
        const int tb0 = G > 128 ? 128 : 0, tnb = G - tb0;
        if (bid >= tb0) {
            PHASE_IDS();
            LAS float* scr = (LAS float*)(lds + wave * 16384);
            constexpr int I_PA = 8 * 32, I_PB = 16 * 32, I_WO = 16 * 32, I_1 = 16 * 128, I_2 = 64 * 32, NIT = I_PA + I_PB + I_WO + I_1 + I_2;
            for (int it = (bid - tb0) * 8 + wave; it < NIT; it += tnb * 8) {
                int r = it;
                if (r < I_PA) { const int nb = r % 32, kb = r / 32; transpose_item(a.in[6], 1536, D, WpcT, 32 * nb, 64 * kb, 64 * kb, 32 * nb + (lane & 31), nullptr, scr, lane); continue; } r -= I_PA;
                if (r < I_PB) { const int nb = r % 32, kb = r / 32; transpose_item(a.in[7], 1536, D, WpcT, 32 * nb, 64 * kb, 512 + 64 * kb, 32 * nb + (lane & 31), nullptr, scr, lane); continue; } r -= I_PB;
                if (r < I_WO) { const int nb = r % 32, kb = r / 32; transpose_item(a.in[8], D, D, WoutT, 32 * nb, 64 * kb, 64 * kb, 32 * nb + (lane & 31), nullptr, scr, lane); continue; } r -= I_WO;
                if (r < I_1) { const int nb = r % 128, kb = r / 128; transpose_item(a.in[10], D, FF, W1T, 32 * nb, 64 * kb, 64 * kb, 32 * nb + (lane & 31), a.in[9], scr, lane); continue; } r -= I_1;
                { const int nb = r % 32, kb = r / 32; transpose_item(a.in[11], FF, D, W2T, 32 * nb, 64 * kb, 64 * kb, 32 * nb + (lane & 31), nullptr, scr, lane); }
            }
        }
    }
    xcd_barrier(xbar);

    {
        PHASE_IDS();
        for (int u = gw; u < 32 * 64 * 4; u += NGW) gla_prep_unit((LAS bf16_t*)(lds + wave * 10240), GQ, GK, GLOW, a.in[3], a.in[4], KT, ED, u >> 8, (u >> 2) & 63, u & 3, lane);
    }
    xcd_barrier(xbar);

    {
        PHASE_IDS();
        for (int u = bid; u < 32 * 7; u += G) gla_state_block(lds, KT, GVT, ED, SLOC, DSEG, u / 7, u % 7);
        for (int u = gw; u < NB * 8 * 128; u += NGW) sb_attn_unit(QH, KH, VT, OC, u >> 10, (u >> 7) & 7, u & 127, lane);
    }
    xcd_barrier(xbar);

    {
        GlaPtrs gp{GQ, GK, GO, GVT, KT, ED, a.in[5], OC, SLOC, DSEG};
        for (int u = bid; u < 256; u += G) gla_out_unit(lds, gp, u >> 3, u & 7);
    }
    xcd_barrier(xbar);

    {
        pg8::Gemm g{OC, WpcT, T, D, 1536}; pg8::StaticOrder S; S.init(T, D, G, bid);
        Epi<E_PMIX> E{}; E.GATES = GATES; E.MIX = MIX;
        pg8::gemm_phase<Epi<E_PMIX>, pg8::StaticOrder, true, true>(lds, g, S, E);
    }
    xcd_barrier(xbar);

    {
        pg8::Gemm g{MIX, WoutT, T, D, D}; pg8::StaticOrder S; S.init(T, D, G, bid);
        Epi<E_WOUT> E{}; E.XIN = x; E.XB = HB; E.SS = SS1;
        pg8::gemm_phase<Epi<E_WOUT>, pg8::StaticOrder, true, true>(lds, g, S, E);
    }
    xcd_barrier(xbar);

    {
        pg8::Gemm g{HB, W1T, T, FF, D}; pg8::StaticOrder S; S.init(T, FF, G, bid);
        Epi<E_FF1> E{}; E.SS = SS1; E.HID = HID;
        pg8::gemm_phase<Epi<E_FF1>, pg8::StaticOrder, true, true>(lds, g, S, E);
    }
    xcd_barrier(xbar);

    {
        pg8::Gemm g{HID, W2T, T, D, FF}; RevOrder S; S.init(T, D, G, bid);
        Epi<E_FF2> E{}; E.XBIN = HB; E.XB = (bf16_t*)(ws + WS_X2B); E.SS = SS2;
        pg8::gemm_phase<Epi<E_FF2>, RevOrder, true, true>(lds, g, S, E);
    }
    xcd_barrier(xbar);

    {
        PHASE_IDS();
        const float* gf = a.in[12];
        const bf16_t* X2B = (const bf16_t*)(ws + WS_X2B);
        for (int m0 = gw * 4; m0 < T; m0 += NGW * 4) {
            u32x2 v[4][4]; float rs[4];
#pragma unroll
            for (int rr = 0; rr < 4; ++rr) { const u32x2* xr = (const u32x2*)(X2B + (size_t)(m0 + rr) * D) + lane; rs[rr] = rsqrtf(SS2[m0 + rr] * (1.f / D) + EPS);
#pragma unroll
                for (int j = 0; j < 4; ++j) v[rr][j] = xr[64 * j]; }
#pragma unroll
            for (int j = 0; j < 4; ++j) { const f32x4 gg = ((const f32x4*)gf)[lane + 64 * j];
#pragma unroll
                for (int rr = 0; rr < 4; ++rr) { const f32x4 xv = (f32x4){bflo(v[rr][j].x), bfhi(v[rr][j].x), bflo(v[rr][j].y), bfhi(v[rr][j].y)};
                    ((f32x4*)(a.out + (size_t)(m0 + rr) * D))[lane + 64 * j] = xv * rs[rr] * gg; } }
        }
    }
}

extern "C" void kernel_launch(void* const* d_in, const int* in_sizes, int n_in, void* d_out, int out_size, void* d_ws, size_t ws_size, hipStream_t stream) {
    static int grid = 0;
    if (grid == 0) {
        if (n_in != 13 || in_sizes[0] != T * D || out_size != T * D || ws_size < WS_END) { fprintf(stderr, "kernel_launch: unexpected shapes (n_in %d, in0 %d, out %d, ws %zu)\n", n_in, n_in > 0 ? in_sizes[0] : -1, out_size, ws_size); grid = -1; return; }
        int dev = 0, cus = 0, per_cu = 0;
        hipGetDevice(&dev); hipDeviceGetAttribute(&cus, hipDeviceAttributeMultiprocessorCount, dev);
        if (hipFuncSetAttribute((const void*)fwd_kernel, hipFuncAttributeMaxDynamicSharedMemorySize, LDS_BYTES) != hipSuccess) { fprintf(stderr, "kernel_launch: hipFuncSetAttribute failed\n"); grid = -1; return; }
        if (hipOccupancyMaxActiveBlocksPerMultiprocessor(&per_cu, (const void*)fwd_kernel, 512, LDS_BYTES) != hipSuccess || per_cu < 1) { fprintf(stderr, "kernel_launch: occupancy query gave %d\n", per_cu); per_cu = 1; }
        (void)hipGetLastError();
        grid = cus * 1;
        fprintf(stderr, "kernel_launch: grid %d (cus %d, per_cu %d)\n", grid, cus, per_cu);
    }
    if (grid < 0) return;
    Args a{};
    for (int i = 0; i < 13; ++i) a.in[i] = (const float*)d_in[i];
    a.out = (float*)d_out; a.ws = (unsigned char*)d_ws;
    void* args[] = {&a};
    hipError_t e = hipLaunchCooperativeKernel((const void*)fwd_kernel, dim3(grid), dim3(512), args, LDS_BYTES, stream);
    if (e != hipSuccess) fprintf(stderr, "cooperative launch failed: %s (grid %d)\n", hipGetErrorString(e), grid);
}
```
